# Optimizing an MI355X kernel written in HIP

```python
import math
import jax, jax.numpy as jnp
from jax import lax
import numpy as np

D_MODEL = 1024
BATCH = 32
SEQ = 2048
DEPTH = 2
DEC_BATCH = 16
DEC_SEQ = 32
PAST_LEN = 2048

CHUNK = 64
N_MIXERS = 2
N_GLA = (DEPTH + 1) // 2
N_DIFF = DEPTH // 2
GLA_HEADS = 4
GLA_DK = D_MODEL // 2 // GLA_HEADS
GLA_DV = D_MODEL // GLA_HEADS
GLA_RANK = 16
GLA_TAU = 16.0
GLA_IN = 2 * GLA_HEADS * GLA_DK + 2 * GLA_HEADS * GLA_DV + GLA_RANK
DIFF_HEADS = D_MODEL // 128
DIFF_HD = 64
DIFF_DV = 2 * DIFF_HD
DIFF_IN = DIFF_HEADS * (4 * DIFF_HD + DIFF_DV)
Q_BLOCK = 128
D_FF = 2816
CONV_W = 3
EPS = 1e-6

kernel_name = 'hybrid_gla_diffattn_convffn_stream_step'


def rms_norm(x, gain):
    xf = x.astype(jnp.float32)
    y = xf * lax.rsqrt(jnp.mean(xf * xf, axis=-1, keepdims=True) + EPS)
    return (y * gain.astype(jnp.float32)).astype(x.dtype)


def adaln(c, w_ada, b_ada):
    m = jnp.einsum('bd,de->be', jax.nn.silu(c), w_ada) + b_ada
    return jnp.split(m, 6, axis=-1)


def modulate(h, shift, scale):
    return h * (1.0 + scale[:, None, :]) + shift[:, None, :]


def gla_chunk_step(S, inp):
    q, k, v, g = inp
    C = q.shape[1]
    b = jnp.cumsum(g, axis=1)
    qe = q * jnp.exp(b)
    ke = k * jnp.exp(-b)
    causal = jnp.tril(jnp.ones((C, C), dtype=bool))
    att = jnp.where(causal, jnp.einsum('bthd,bshd->bhts', qe, ke), 0.0)
    o = jnp.einsum('bthd,bhde->bthe', qe, S) + jnp.einsum('bhts,bshe->bthe', att, v)
    b_last = b[:, -1]
    k_dec = k * jnp.exp(b_last[:, None] - b)
    S_new = jnp.exp(b_last)[..., None] * S + jnp.einsum('bshd,bshe->bhde', k_dec, v)
    return S_new, o


def gla_mixer(h, S0, w_in, w_alpha, b_alpha, norm_g, w_out):
    B, T, _ = h.shape
    nq = GLA_HEADS * GLA_DK
    nv = GLA_HEADS * GLA_DV
    proj = jnp.einsum('btd,de->bte', h, w_in)
    q, k, v, r, a_low = jnp.split(proj, [nq, 2 * nq, 2 * nq + nv, 2 * nq + 2 * nv], axis=-1)
    logit = jnp.einsum('btr,re->bte', a_low, w_alpha) + b_alpha
    g = jax.nn.log_sigmoid(logit.astype(jnp.float32)) / GLA_TAU
    C = min(CHUNK, T)
    n = T // C

    def chunks(a, dh):
        return a.astype(jnp.float32).reshape(B, n, C, GLA_HEADS, dh).swapaxes(0, 1)

    S_fin, o = lax.scan(gla_chunk_step, S0.astype(jnp.float32),
                        (chunks(q * GLA_DK ** -0.5, GLA_DK), chunks(k, GLA_DK),
                         chunks(v, GLA_DV), chunks(g, GLA_DK)))
    o = o.swapaxes(0, 1).reshape(B, T, GLA_HEADS, GLA_DV)
    o = rms_norm(o, norm_g).astype(h.dtype) * jax.nn.silu(r).reshape(B, T, GLA_HEADS, GLA_DV)
    out = jnp.einsum('bthe,hed->btd', o, w_out.reshape(GLA_HEADS, GLA_DV, D_MODEL))
    return out, S_fin.astype(S0.dtype)


def diff_project(h, w_in, q_gain, k_gain):
    B, T, _ = h.shape
    nqk = DIFF_HEADS * 2 * DIFF_HD
    proj = jnp.einsum('btd,de->bte', h, w_in)
    q, k, v = jnp.split(proj, [nqk, 2 * nqk], axis=-1)
    q = rms_norm(q.reshape(B, T, DIFF_HEADS, 2, DIFF_HD), q_gain)
    k = rms_norm(k.reshape(B, T, DIFF_HEADS, 2, DIFF_HD), k_gain)
    v = v.reshape(B, T, DIFF_HEADS, DIFF_DV)
    return q, k, v


def diff_attend(q, k, v, q_offset, lam):
    B, T = q.shape[:2]
    Tk = k.shape[1]
    qb = min(Q_BLOCK, T)
    nb = T // qb
    q_blocks = q.reshape(B, nb, qb, DIFF_HEADS, 2, DIFF_HD).swapaxes(0, 1)
    k_chunk = jnp.arange(Tk) // CHUNK
    scale = DIFF_HD ** -0.5

    def one_block(args):
        q_blk, j = args
        q_pos = q_offset + j * qb + jnp.arange(qb)
        mask = k_chunk[None, :] <= (q_pos // CHUNK)[:, None]
        s = jnp.einsum('bqhcd,bkhcd->bhcqk', q_blk, k).astype(jnp.float32) * scale
        p = jax.nn.softmax(jnp.where(mask, s, -jnp.inf), axis=-1)
        a = p[:, :, 0] - lam * p[:, :, 1]
        return jnp.einsum('bhqk,bkhe->bqhe', a.astype(v.dtype), v)

    o = lax.map(one_block, (q_blocks, jnp.arange(nb)))
    return o.swapaxes(0, 1).reshape(B, T, DIFF_HEADS, DIFF_DV)


def conv_ffn(h, conv_state, w_in, conv_w, conv_b, w_out):
    T = h.shape[1]
    up = jnp.einsum('btd,de->bte', h, w_in)
    padded = jnp.concatenate([conv_state.astype(up.dtype), up], axis=1)
    conv = conv_b + conv_w[0] * padded[:, 0:T]
    for j in range(1, CONV_W):
        conv = conv + conv_w[j] * padded[:, j:j + T]
    u, gate = jnp.split(conv, 2, axis=-1)
    y = jnp.einsum('btf,fd->btd', jax.nn.silu(gate) * u, w_out)
    return y, padded[:, T:]


def setup_inputs(seed: int = 0) -> dict:
    key = jax.random.key(seed)
    ks = jax.random.split(key, 32)
    f32 = jnp.float32

    def nrm(k, shape, scale):
        return jax.random.normal(k, shape, f32) * scale

    nq = GLA_HEADS * GLA_DK
    nv = GLA_HEADS * GLA_DV
    return {
        'x_prompt': nrm(ks[0], (BATCH, SEQ, D_MODEL), 1.0),
        'x_sample': nrm(ks[1], (DEC_BATCH, DEC_SEQ, D_MODEL), 1.0),
        'state_gla': nrm(ks[2], (N_GLA, DEC_BATCH, GLA_HEADS, GLA_DK, GLA_DV), 0.5),
        'cache_diff_k': nrm(ks[3], (N_DIFF, DEC_BATCH, PAST_LEN, DIFF_HEADS, 2, DIFF_HD), 1.0),
        'cache_diff_v': nrm(ks[4], (N_DIFF, DEC_BATCH, PAST_LEN, DIFF_HEADS, DIFF_DV), 1.0),
        'state_ffn_conv': nrm(ks[5], (DEPTH, DEC_BATCH, CONV_W - 1, 2 * D_FF), 0.5),
        'c_prompt': nrm(ks[6], (BATCH, D_MODEL), 1.0),
        'c_sample': nrm(ks[7], (DEC_BATCH, D_MODEL), 1.0),
        'norm_mix': 1.0 + nrm(ks[8], (DEPTH, D_MODEL), 0.01),
        'norm_ffn': 1.0 + nrm(ks[9], (DEPTH, D_MODEL), 0.01),
        'w_ada': nrm(ks[10], (DEPTH, D_MODEL, 6 * D_MODEL), 0.5 * D_MODEL ** -0.5),
        'b_ada': nrm(ks[11], (DEPTH, 6 * D_MODEL), 0.01),
        'gla_w_in': nrm(ks[12], (N_GLA, D_MODEL, GLA_IN), D_MODEL ** -0.5),
        'gla_w_alpha': nrm(ks[13], (N_GLA, GLA_RANK, nq), GLA_RANK ** -0.5),
        'gla_b_alpha': nrm(ks[14], (N_GLA, nq), 0.1),
        'gla_norm': 1.0 + nrm(ks[15], (N_GLA, GLA_DV), 0.01),
        'gla_w_out': nrm(ks[16], (N_GLA, nv, D_MODEL), nv ** -0.5),
        'diff_w_in': nrm(ks[17], (N_DIFF, D_MODEL, DIFF_IN), D_MODEL ** -0.5),
        'diff_q_norm': 1.0 + nrm(ks[18], (N_DIFF, DIFF_HD), 0.01),
        'diff_k_norm': 1.0 + nrm(ks[19], (N_DIFF, DIFF_HD), 0.01),
        'diff_lambda': nrm(ks[20], (N_DIFF, 4, DIFF_HD), 0.1),
        'diff_norm': 1.0 + nrm(ks[21], (N_DIFF, DIFF_DV), 0.01),
        'diff_w_out': nrm(ks[22], (N_DIFF, DIFF_HEADS * DIFF_DV, D_MODEL), (DIFF_HEADS * DIFF_DV) ** -0.5),
        'ffn_w_in': nrm(ks[23], (DEPTH, D_MODEL, 2 * D_FF), D_MODEL ** -0.5),
        'ffn_conv_w': nrm(ks[24], (DEPTH, CONV_W, 2 * D_FF), CONV_W ** -0.5),
        'ffn_conv_b': nrm(ks[25], (DEPTH, 2 * D_FF), 0.01),
        'ffn_w_out': nrm(ks[26], (DEPTH, D_FF, D_MODEL), D_FF ** -0.5),
    }


def reference(x_prompt, x_sample, state_gla, cache_diff_k, cache_diff_v, state_ffn_conv,
              c_prompt, c_sample, norm_mix, norm_ffn, w_ada, b_ada,
              gla_w_in, gla_w_alpha, gla_b_alpha, gla_norm, gla_w_out,
              diff_w_in, diff_q_norm, diff_k_norm, diff_lambda, diff_norm, diff_w_out,
              ffn_w_in, ffn_conv_w, ffn_conv_b, ffn_w_out):
    xs = [x_prompt, x_sample]
    cs = [c_prompt, c_sample]
    new_gla = [[], []]
    new_k = [[], []]
    new_v = [[], []]
    new_conv = [[], []]
    for i in range(DEPTH):
        j = i // N_MIXERS
        lam_init = 0.8 - 0.6 * math.exp(-0.3 * i)
        for grp in range(2):
            x = xs[grp]
            B = x.shape[0]
            sh1, sc1, gt1, sh2, sc2, gt2 = adaln(cs[grp], w_ada[i], b_ada[i])
            h = modulate(rms_norm(x, norm_mix[i]), sh1, sc1)
            if i % N_MIXERS == 0:
                S0 = jnp.zeros((B, GLA_HEADS, GLA_DK, GLA_DV), x.dtype) if grp == 0 else state_gla[j]
                mix, S_fin = gla_mixer(h, S0, gla_w_in[j], gla_w_alpha[j], gla_b_alpha[j],
                                       gla_norm[j], gla_w_out[j])
                new_gla[grp].append(S_fin)
            else:
                q, k, v = diff_project(h, diff_w_in[j], diff_q_norm[j], diff_k_norm[j])
                lq1, lk1, lq2, lk2 = diff_lambda[j].astype(jnp.float32)
                lam = jnp.exp(jnp.sum(lq1 * lk1)) - jnp.exp(jnp.sum(lq2 * lk2)) + lam_init
                if grp == 0:
                    o = diff_attend(q, k, v, 0, lam)
                else:
                    k_all = jnp.concatenate([cache_diff_k[j].astype(k.dtype), k], axis=1)
                    v_all = jnp.concatenate([cache_diff_v[j].astype(v.dtype), v], axis=1)
                    o = diff_attend(q, k_all, v_all, PAST_LEN, lam)
                o = rms_norm(o, diff_norm[j]) * (1.0 - lam_init)
                mix = jnp.einsum('bthe,hed->btd', o, diff_w_out[j].reshape(DIFF_HEADS, DIFF_DV, D_MODEL))
                new_k[grp].append(k)
                new_v[grp].append(v)
            x = x + gt1[:, None, :] * mix
            h = modulate(rms_norm(x, norm_ffn[i]), sh2, sc2)
            cst = jnp.zeros((B, CONV_W - 1, 2 * D_FF), x.dtype) if grp == 0 else state_ffn_conv[i]
            f, cst_new = conv_ffn(h, cst, ffn_w_in[i], ffn_conv_w[i], ffn_conv_b[i], ffn_w_out[i])
            new_conv[grp].append(cst_new)
            xs[grp] = x + gt2[:, None, :] * f
    y_prompt = xs[0]
    y_sample = xs[1]
    new_state_gla_prompt = jnp.stack(new_gla[0])
    new_state_gla_sample = jnp.stack(new_gla[1])
    new_k_prompt = jnp.stack(new_k[0])
    new_k_sample = jnp.stack(new_k[1])
    new_v_prompt = jnp.stack(new_v[0])
    new_v_sample = jnp.stack(new_v[1])
    new_conv_prompt = jnp.stack(new_conv[0])
    new_conv_sample = jnp.stack(new_conv[1])
    return (y_prompt, y_sample, new_state_gla_prompt, new_state_gla_sample,
            new_k_prompt, new_k_sample, new_v_prompt, new_v_sample,
            new_conv_prompt, new_conv_sample)
```

```cpp
#include <hip/hip_runtime.h>
#include <hip/hip_cooperative_groups.h>
#include <cstdint>
#include <cstdio>
namespace cg = cooperative_groups;

#define LAS __attribute__((address_space(3)))
typedef short s16x4 __attribute__((ext_vector_type(4)));
typedef float f32x16 __attribute__((ext_vector_type(16)));
typedef unsigned u32x2 __attribute__((ext_vector_type(2)));
typedef float f32x2_t __attribute__((ext_vector_type(2)));
typedef __bf16 bf16x2_t __attribute__((ext_vector_type(2)));
typedef short v4i16_t __attribute__((ext_vector_type(4)));

constexpr int DM = 1024, MP = 65536, MS = 512, MTOT = MP + MS, NB = 48;
constexpr int GIN = 3088, GIN_PAD = 3328, FF = 2816, FF2 = 5632, DIN = 3072, MODW = 6144;
constexpr float EPS = 1e-6f;
constexpr float LAM_INIT1 = 0.35550906759f;
constexpr float QSCALE = 0.125f * 1.4426950408889634f;
constexpr float GLA_QSC = 0.08838834764831845f;

constexpr size_t O_Y = 0, O_GSP = 67633152, O_GSS = 71827456, O_KP = 73924608, O_KS = 141033472, O_VP = 141557760, O_VS = 208666624, O_CP = 209190912, O_CS = 209911808;

constexpr size_t MiB = 1u << 20;
constexpr size_t WS_BAR = 2621440;
constexpr size_t WS_MOD = 0, WS_SHW = 3 * MiB, WS_SSQ = 7 * MiB, WS_ALOW = 9 * MiB, WS_HF = 14 * MiB, WS_HL = 26 * MiB;
constexpr size_t WS_WGI = 38 * MiB, WS_WGO = 45 * MiB, WS_WDI = 47 * MiB, WS_WDO = 53 * MiB, WS_WU0 = 55 * MiB, WS_WU1 = 66 * MiB, WS_WD0 = 77 * MiB, WS_WD1 = 83 * MiB;
constexpr size_t WS_XM = 90 * MiB, WS_O = 220 * MiB, WS_QKVR = 350 * MiB, WS_KC = 738 * MiB, WS_VC = 802 * MiB, WS_END = 866 * MiB;
constexpr size_t SHW_GLA = 0, SHW_UP0 = (size_t)NB * GIN_PAD, SHW_DIF = SHW_UP0 + (size_t)NB * FF2, SHW_UP1 = SHW_DIF + (size_t)NB * DIN;

constexpr int XL_OFF = 131072;
constexpr int LDS_BYTES = 163840;
constexpr int PT_OFF = 163584;

__device__ __forceinline__ unsigned pk2(float lo, float hi) { f32x2_t v = {lo, hi}; bf16x2_t b = __builtin_convertvector(v, bf16x2_t); return __builtin_bit_cast(unsigned, b); }
__device__ __forceinline__ float bflo(unsigned u) { return __uint_as_float(u << 16); }
__device__ __forceinline__ float bfhi(unsigned u) { return __uint_as_float(u & 0xffff0000u); }
__device__ __forceinline__ float bf2f(unsigned short u) { return __uint_as_float(((unsigned)u) << 16); }
__device__ __forceinline__ unsigned short f2bf(float f) { return (unsigned short)(pk2(f, 0.f) & 0xffffu); }
__device__ __forceinline__ float silu_f(float x) { return x * __builtin_amdgcn_rcpf(1.f + __expf(-x)); }
__device__ __forceinline__ int bidx_of(int row) { return row < MP ? (row >> 11) : 32 + ((row - MP) >> 5); }
__device__ __forceinline__ int crow(int r, int hi) { return (r & 3) + 8 * (r >> 2) + 4 * hi; }
__device__ __forceinline__ float wave_sum(float v) {
#pragma unroll
    for (int o = 1; o < 64; o <<= 1) v += __shfl_xor(v, o);
    return v;
}
#define MFMA32(a, b, c) __builtin_amdgcn_mfma_f32_32x32x16_bf16((a), (b), (c), 0, 0, 0)

namespace pg8 {
#define PG8_LAS __attribute__((address_space(3)))
typedef unsigned short bf16_t;
typedef short bf16x8 __attribute__((ext_vector_type(8)));
typedef float f32x4 __attribute__((ext_vector_type(4)));
typedef unsigned u32x4 __attribute__((ext_vector_type(4)));
constexpr int BM = 256, BK = 64, HALF = 128, HTB = HALF * BK * 2  , STAGE_BYTES = 8 * HTB, NXCD = 8, WGM = 8;

__host__ __device__ __forceinline__ int lds_byte(int r, int c) { const int st = (r >> 4) * 2 + (c >> 5), rr = r & 15, cc = c & 31, ob = rr * 64 + cc * 2; return st * 1024 + (ob ^ (((ob >> 9) & 1) << 5)); }
__host__ __device__ __forceinline__ void stage_rc(int b, int& R, int& C) { const int st = b / 1024, sb = b % 1024, swz = sb ^ (((sb >> 9) & 1) << 5); R = (st >> 1) * 16 + swz / 64; C = (st & 1) * 32 + (swz % 64) / 2; }
__host__ __device__ __forceinline__ int perm32(int rho) { const int n = rho >> 4, i = rho & 15; return 8 * (i >> 2) + 4 * n + (i & 3); }

struct Unit { int pm, pn; };
struct Gemm { const bf16_t* A; const bf16_t* Bt; int M, N, K; };

struct StaticOrder {
    int nM, nN, nwg, G, c;
    __host__ __device__ void init(int M, int N, int G_, int c_) { nM = M / BM; nN = N / BM; nwg = nM * nN; G = G_; c = c_; }
    __host__ __device__ bool next(int i, Unit& u) const {
        const long L = (long)i * G + c; if (L >= nwg) return false;
        int wgid = (int)L; { const int q = nwg / NXCD, r = nwg % NXCD, xcd = wgid % NXCD, off = wgid / NXCD; wgid = (xcd < r ? xcd * (q + 1) : r * (q + 1) + (xcd - r) * q) + off; }
        const int nig = WGM * nN, gid = wgid / nig, fm = gid * WGM, gsz = (nM - fm) < WGM ? (nM - fm) : WGM;
        u.pm = fm + ((wgid % nig) % gsz); u.pn = (wgid % nig) / gsz; return true;
    }
    __device__ __forceinline__ void a_ready(const Unit&) const {}
    __device__ __forceinline__ void done(const Unit&) const {}
};

template <class Epi, class Sched, bool ALIGN_EPI, bool SP2, bool ROWPERM>
__device__ __forceinline__ void gemm_phase(PG8_LAS unsigned char* lds, const Gemm g, const Sched& S, const Epi& E, PG8_LAS unsigned char* xl) {
    int tid_ = threadIdx.x; asm volatile("" : "+v"(tid_));
    const int tid = tid_, wid = __builtin_amdgcn_readfirstlane(tid >> 6), lane = tid & 63, wr = wid >> 2, wc = wid & 3, fr = lane & 15, fq = lane >> 4;
    const int K = g.K, nt = K / BK;
    unsigned voffA[2], voffB[2];
#pragma unroll
    for (int i = 0; i < 2; ++i) { int R, C; stage_rc(tid * 16 + i * 8192, R, C); const int Rb = Epi::PERM ? ((R & ~31) + perm32(R & 31)) : R;
        const int Ra = ROWPERM ? (((R >> 6) & 1) * 128 + (R & 15) * 8 + ((R >> 4) & 3)) : R;
        voffA[i] = (unsigned)(Ra * K + C) * 2u; voffB[i] = (unsigned)(Rb * K + C) * 2u; }
    const size_t kstep = (size_t)(BK * 2);
    const size_t hstep = (size_t)HALF * K * 2; const size_t hstepA = ROWPERM ? (size_t)4 * K * 2 : hstep;
    const size_t tstep = 2 * hstep;
    const unsigned ldsw = (unsigned)wid * 1024u;
    const int aoff = lds_byte(wr * 64 + fr, fq * 8), boff = lds_byte(wc * 32 + fr, fq * 8);
#define PG8_SA(b, h) (((b) * 2 + (h)) * HTB)
#define PG8_SB(b, h) ((4 + (b) * 2 + (h)) * HTB)
#define PG8_STAGE(bufoff, gbase, voff) do { _Pragma("unroll") for (int _i = 0; _i < 2; ++_i) \
        __builtin_amdgcn_global_load_lds((const unsigned*)((const char*)(gbase) + (voff)[_i]), (PG8_LAS unsigned*)(lds + (bufoff) + ldsw + _i * 8192), 16, 0, 0); } while (0)
#define PG8_LDA(dst, b, h) do { _Pragma("unroll") for (int m = 0; m < 4; ++m) _Pragma("unroll") for (int k = 0; k < 2; ++k) dst[m][k] = *(const PG8_LAS bf16x8*)(lds + PG8_SA(b, h) + aoff + m * 2048 + k * 1024); } while (0)
#define PG8_LDB(dst, b, h) do { _Pragma("unroll") for (int n = 0; n < 2; ++n) _Pragma("unroll") for (int k = 0; k < 2; ++k) dst[n][k] = *(const PG8_LAS bf16x8*)(lds + PG8_SB(b, h) + boff + n * 2048 + k * 1024); } while (0)
#define PG8_MMA(ai, bj, At, Bt) do { __builtin_amdgcn_s_setprio(1); _Pragma("unroll") for (int m = 0; m < 4; ++m) _Pragma("unroll") for (int n = 0; n < 2; ++n) _Pragma("unroll") for (int k = 0; k < 2; ++k) \
        acc[ai][bj][m][n] = __builtin_amdgcn_mfma_f32_16x16x32_bf16(Bt[n][k], At[m][k], acc[ai][bj][m][n], 0, 0, 0); __builtin_amdgcn_s_setprio(0); } while (0)
#define PG8_WAIT_V(n) asm volatile("s_waitcnt vmcnt(" #n ")" ::: "memory")
#define PG8_WAIT_L(n) asm volatile("s_waitcnt lgkmcnt(" #n ")" ::: "memory")
#define PG8_BAR __builtin_amdgcn_s_barrier()
#define PG8_SCHED __builtin_amdgcn_sched_barrier(0)
    Unit cur, nxt; int ui = 0;
    if (!S.next(0, cur)) return;
    f32x4 acc[2][2][4][2];
#pragma unroll
    for (int a = 0; a < 2; ++a)
#pragma unroll
        for (int b = 0; b < 2; ++b)
#pragma unroll
            for (int m = 0; m < 4; ++m)
#pragma unroll
                for (int n = 0; n < 2; ++n) acc[a][b][m][n] = (f32x4){0.f, 0.f, 0.f, 0.f};
    bf16x8 At[4][2], B0[2][2], B1[2][2];
    const char* cA = (const char*)g.A + (size_t)cur.pm * tstep; const char* cB = (const char*)g.Bt + (size_t)cur.pn * tstep;

    if constexpr (SP2) {
        PG8_STAGE(PG8_SB(0, 0), cB, voffB); PG8_STAGE(PG8_SB(0, 1), cB + hstep, voffB); PG8_STAGE(PG8_SA(0, 0), cA, voffA); PG8_STAGE(PG8_SA(0, 1), cA + hstepA, voffA);
        if (wr == 1) PG8_BAR;
        PG8_WAIT_V(2); PG8_BAR;
        PG8_STAGE(PG8_SB(1, 0), cB + kstep, voffB); PG8_STAGE(PG8_SA(1, 0), cA + kstep, voffA); PG8_STAGE(PG8_SB(1, 1), cB + hstep + kstep, voffB);
        PG8_WAIT_V(6); PG8_BAR;
    } else {
        PG8_STAGE(PG8_SB(0, 0), cB, voffB); PG8_STAGE(PG8_SA(0, 0), cA, voffA); PG8_STAGE(PG8_SB(0, 1), cB + hstep, voffB); PG8_STAGE(PG8_SA(0, 1), cA + hstepA, voffA);
        if (wr == 1) PG8_BAR;
        PG8_WAIT_V(4); PG8_BAR;
        PG8_STAGE(PG8_SB(1, 0), cB + kstep, voffB); PG8_STAGE(PG8_SA(1, 0), cA + kstep, voffA); PG8_STAGE(PG8_SB(1, 1), cB + hstep + kstep, voffB);
        PG8_WAIT_V(6); PG8_BAR;
    }
    for (;;) {
        const bool has_next = S.next(ui + 1, nxt);
        const char* nA = has_next ? (const char*)g.A + (size_t)nxt.pm * tstep : cA; const char* nB = has_next ? (const char*)g.Bt + (size_t)nxt.pn * tstep : cB;
        for (int t = 0; t < nt; t += 2) {
            const bool last = (t == nt - 2);
            const char* a1 = cA + (size_t)(t + 1) * kstep;
            const char* a2 = last ? nA : cA + (size_t)(t + 2) * kstep; const char* b2 = last ? nB : cB + (size_t)(t + 2) * kstep;
            const char* a3 = a2 + kstep; const char* b3 = b2 + kstep;

            if constexpr (SP2) {
            PG8_LDB(B0, 0, 0); PG8_LDB(B1, 0, 1); PG8_SCHED; PG8_LDA(At, 0, 0); PG8_STAGE(PG8_SA(1, 1), a1 + hstepA, voffA);
            PG8_WAIT_V(8); PG8_WAIT_L(0); PG8_BAR; PG8_MMA(0, 0, At, B0); PG8_MMA(0, 1, At, B1); PG8_BAR; PG8_SCHED;
            PG8_LDA(At, 0, 1); PG8_STAGE(PG8_SB(0, 0), b2, voffB); PG8_STAGE(PG8_SB(0, 1), b2 + hstep, voffB); PG8_STAGE(PG8_SA(0, 0), a2, voffA);
            PG8_WAIT_V(8); PG8_WAIT_L(0); PG8_BAR; PG8_MMA(1, 0, At, B0); PG8_MMA(1, 1, At, B1); PG8_BAR; PG8_SCHED;
            PG8_LDB(B0, 1, 0); PG8_LDB(B1, 1, 1); PG8_SCHED; PG8_LDA(At, 1, 0); PG8_STAGE(PG8_SA(0, 1), a2 + hstepA, voffA);
            PG8_WAIT_V(8); PG8_WAIT_L(0); PG8_BAR; PG8_MMA(0, 0, At, B0); PG8_MMA(0, 1, At, B1); PG8_BAR; PG8_SCHED;
            PG8_LDA(At, 1, 1); PG8_STAGE(PG8_SB(1, 0), b3, voffB); PG8_STAGE(PG8_SB(1, 1), b3 + hstep, voffB); PG8_STAGE(PG8_SA(1, 0), a3, voffA);
            PG8_WAIT_V(8); PG8_WAIT_L(0); PG8_BAR; PG8_MMA(1, 0, At, B0); PG8_MMA(1, 1, At, B1); PG8_BAR; PG8_SCHED;
            } else {
            PG8_LDB(B0, 0, 0); PG8_SCHED; PG8_LDA(At, 0, 0); PG8_STAGE(PG8_SA(1, 1), a1 + hstepA, voffA);
            PG8_WAIT_L(8); PG8_BAR; PG8_WAIT_L(0); PG8_MMA(0, 0, At, B0); PG8_BAR; PG8_SCHED;
            PG8_LDB(B1, 0, 1); PG8_STAGE(PG8_SB(0, 0), b2, voffB);
            PG8_BAR; PG8_WAIT_L(0); PG8_MMA(0, 1, At, B1); PG8_BAR;
            PG8_LDA(At, 0, 1); PG8_STAGE(PG8_SA(0, 0), a2, voffA);
            PG8_BAR; PG8_WAIT_L(0); PG8_MMA(1, 0, At, B0); PG8_BAR; PG8_SCHED;
            PG8_STAGE(PG8_SB(0, 1), b2 + hstep, voffB);
            PG8_WAIT_V(6); PG8_BAR; PG8_MMA(1, 1, At, B1); PG8_BAR;
            PG8_LDB(B0, 1, 0); PG8_SCHED; PG8_LDA(At, 1, 0); PG8_STAGE(PG8_SA(0, 1), a2 + hstepA, voffA);
            PG8_WAIT_L(8); PG8_BAR; PG8_WAIT_L(0); PG8_MMA(0, 0, At, B0); PG8_BAR; PG8_SCHED;
            PG8_LDB(B1, 1, 1); PG8_STAGE(PG8_SB(1, 0), b3, voffB);
            PG8_BAR; PG8_WAIT_L(0); PG8_MMA(0, 1, At, B1); PG8_BAR;
            PG8_LDA(At, 1, 1); PG8_STAGE(PG8_SA(1, 0), a3, voffA);
            PG8_BAR; PG8_WAIT_L(0); PG8_MMA(1, 0, At, B0); PG8_BAR; PG8_SCHED;
            PG8_STAGE(PG8_SB(1, 1), b3 + hstep, voffB);
            PG8_WAIT_V(6); PG8_BAR; PG8_MMA(1, 1, At, B1); PG8_BAR;
            }
        }
        if constexpr (ALIGN_EPI) { if (wr == 0) PG8_BAR; }
        E(acc, cur, wr, wc, fr, fq, xl);
        if (!has_next) break;
#pragma unroll
        for (int a = 0; a < 2; ++a)
#pragma unroll
            for (int b = 0; b < 2; ++b)
#pragma unroll
                for (int m = 0; m < 4; ++m)
#pragma unroll
                    for (int n = 0; n < 2; ++n) acc[a][b][m][n] = (f32x4){0.f, 0.f, 0.f, 0.f};
        cur = nxt; cA = nA; cB = nB; ++ui;
        if constexpr (ALIGN_EPI) { if (wr == 1) PG8_BAR; }
    }
    PG8_WAIT_V(0);
    if constexpr (!ALIGN_EPI) { if (wr == 0) PG8_BAR; }
    PG8_BAR;
#undef PG8_SA
#undef PG8_SB
#undef PG8_STAGE
#undef PG8_LDA
#undef PG8_LDB
#undef PG8_MMA
#undef PG8_WAIT_V
#undef PG8_WAIT_L
#undef PG8_BAR
#undef PG8_SCHED
}
}

using pg8::bf16_t; using pg8::bf16x8; using pg8::f32x4; using pg8::u32x4;
typedef const f32x4 (&AccRef)[2][2][4][2];

struct EpiGlaIn {
    static constexpr bool PERM = true;
    bf16_t* QKVR; float* alow; const float* ssq; const float* shW;
    __device__ __forceinline__ void operator()(AccRef acc, const pg8::Unit& u, int wr, int wc, int fr, int fq, LAS unsigned char*) const {
        const int colt = u.pn * 256 + wc * 32 + 8 * fq;
#pragma unroll
        for (int ai = 0; ai < 2; ++ai)
#pragma unroll
            for (int m = 0; m < 4; ++m) {
                const int row = u.pm * 256 + ai * 128 + wr * 64 + m * 16 + fr; const int b = bidx_of(row);
                const float rs = rsqrtf(ssq[row] * (1.f / 1024.f) + EPS);
#pragma unroll
                for (int bj = 0; bj < 2; ++bj) {
                    const int col = colt + bj * 128;
                    const f32x4 b0 = *(const f32x4*)(shW + (size_t)b * GIN_PAD + col), b1 = *(const f32x4*)(shW + (size_t)b * GIN_PAD + col + 4);
                    const f32x4 v0 = acc[ai][bj][m][0] * rs + b0, v1 = acc[ai][bj][m][1] * rs + b1;
                    if (u.pn < 12) { u32x4 w; w.x = pk2(v0[0], v0[1]); w.y = pk2(v0[2], v0[3]); w.z = pk2(v1[0], v1[1]); w.w = pk2(v1[2], v1[3]); *(u32x4*)(QKVR + (size_t)row * 3072 + col) = w; }
                    else if (col < GIN) { float* p = alow + (size_t)row * 16 + (col - 3072); *(f32x4*)p = v0; *(f32x4*)(p + 4) = v1; }
                }
            }
    }
};

struct EpiRes {
    static constexpr bool PERM = true;
    const float* xin_p; const float* xin_s; float* xout; bf16_t* XM; float* ssq_out; const float* gt; const float* sc; const float* gain; int last;
    __device__ __forceinline__ void operator()(AccRef acc, const pg8::Unit& u, int wr, int wc, int fr, int fq, LAS unsigned char*) const {
        const int colt = u.pn * 256 + wc * 32 + 8 * fq;
#pragma unroll
        for (int ai = 0; ai < 2; ++ai)
#pragma unroll
            for (int m = 0; m < 4; ++m) {
                const int row = u.pm * 256 + ai * 128 + wr * 64 + m * 16 + fr; const int b = bidx_of(row);
                const float* xin = row < MP ? xin_p + (size_t)row * DM : xin_s + (size_t)(row - MP) * DM;
                float ss = 0.f;
#pragma unroll
                for (int bj = 0; bj < 2; ++bj) {
                    const int col = colt + bj * 128;
                    const f32x4 g0 = *(const f32x4*)(gt + (size_t)b * MODW + col), g1 = *(const f32x4*)(gt + (size_t)b * MODW + col + 4);
                    const f32x4 x0 = *(const f32x4*)(xin + col), x1 = *(const f32x4*)(xin + col + 4);
                    const f32x4 y0 = x0 + g0 * acc[ai][bj][m][0], y1 = x1 + g1 * acc[ai][bj][m][1];
                    float* op = xout + (size_t)row * DM + col; *(f32x4*)op = y0; *(f32x4*)(op + 4) = y1;
                    if (!last) {
                        const f32x4 s0 = *(const f32x4*)(gain + col) * (*(const f32x4*)(sc + (size_t)b * MODW + col) + 1.f), s1 = *(const f32x4*)(gain + col + 4) * (*(const f32x4*)(sc + (size_t)b * MODW + col + 4) + 1.f);
                        const f32x4 z0 = y0 * s0, z1 = y1 * s1;
                        u32x4 w; w.x = pk2(z0[0], z0[1]); w.y = pk2(z0[2], z0[3]); w.z = pk2(z1[0], z1[1]); w.w = pk2(z1[2], z1[3]);
                        *(u32x4*)(XM + (size_t)row * DM + col) = w;
                        ss += (y0[0] * y0[0] + y0[1] * y0[1]) + (y0[2] * y0[2] + y0[3] * y0[3]) + (y1[0] * y1[0] + y1[1] * y1[1]) + (y1[2] * y1[2] + y1[3] * y1[3]);
                    }
                }
                if (!last) { ss += __shfl_xor(ss, 16); ss += __shfl_xor(ss, 32); if (fq == 0) atomicAdd(ssq_out + row, ss); }
            }
    }
};


__device__ __forceinline__ void thin_res_item(const bf16_t* A, const bf16_t* Bt, int K, int item, const EpiRes& E) {
    int tid_ = threadIdx.x; asm volatile("" : "+v"(tid_));
    const int tid = tid_, lane = tid & 63, wave = __builtin_amdgcn_readfirstlane(tid >> 6), fr = lane & 15, fq = lane >> 4;
    const int rg = item >> 3, cg = item & 7, n0 = cg * 128 + wave * 16;
    const int row = MP + rg * 16 + fr;
    const bf16_t* ap = A + (size_t)(MP + rg * 16) * K;
    const bf16_t* bp = Bt + (size_t)n0 * K;
    const unsigned lo = (unsigned)(fr * K + 8 * fq);
    f32x4 acc = {0.f, 0.f, 0.f, 0.f};
#pragma unroll 8
    for (int k0 = 0; k0 < K; k0 += 32) {
        const bf16x8 a = *(const bf16x8*)(ap + lo + k0), b = *(const bf16x8*)(bp + lo + k0);
        acc = __builtin_amdgcn_mfma_f32_16x16x32_bf16(b, a, acc, 0, 0, 0);
    }
    const int col = n0 + 4 * fq; const int bb = bidx_of(row);
    const float* xin = E.xin_s + (size_t)(row - MP) * DM;
    const f32x4 g = *(const f32x4*)(E.gt + (size_t)bb * MODW + col), x = *(const f32x4*)(xin + col);
    const f32x4 y = x + g * acc;
    *(f32x4*)(E.xout + (size_t)row * DM + col) = y;
    if (!E.last) {
        const f32x4 s = *(const f32x4*)(E.gain + col) * (*(const f32x4*)(E.sc + (size_t)bb * MODW + col) + 1.f), z = y * s;
        *(u32x2*)(E.XM + (size_t)row * DM + col) = (u32x2){pk2(z[0], z[1]), pk2(z[2], z[3])};
        float ss = (y[0] * y[0] + y[1] * y[1]) + (y[2] * y[2] + y[3] * y[3]);
        ss += __shfl_xor(ss, 16); ss += __shfl_xor(ss, 32);
        if (fq == 0) atomicAdd(E.ssq_out + row, ss);
    }
}

struct EpiUp {
    static constexpr bool PERM = true;
    bf16_t* ACT; float* Hfirst; float* Hlast; const float* ssq; const float* shW; const float* cw; const float* cb; const float* cstate; float* ncp; float* ncs;
    __device__ __forceinline__ void operator()(AccRef acc, const pg8::Unit& u, int wr, int wc, int fr, int fq, LAS unsigned char* xl) const {
        const int pm = u.pm, f0 = u.pn * 128 + wc * 32 + 8 * fq, toff = wr * 128 + fr * 8, row0 = pm * 256 + toff;
        const bool samp = pm >= 256;
        const int b = samp ? 32 + (pm - 256) * 8 + (toff >> 5) : (pm >> 3);
        const bool defer = !samp && wr == 0 && fr == 0, lastlane = !samp && wr == 1 && fr == 15, seqstart = samp && (fr & 3) == 0;
        float rs[8];
        { const f32x4 q0 = *(const f32x4*)(ssq + row0), q1 = *(const f32x4*)(ssq + row0 + 4);
#pragma unroll
          for (int j = 0; j < 4; ++j) { rs[j] = rsqrtf(q0[j] * (1.f / 1024.f) + EPS); rs[4 + j] = rsqrtf(q1[j] * (1.f / 1024.f) + EPS); } }
        const float* shb = shW + (size_t)b * FF2;
        LAS float* xf = (LAS float*)xl + (wc * 4 + fq) * 32;
        if (wr == 0 && fr == 15) {
#pragma unroll
            for (int n = 0; n < 2; ++n) {
                const f32x4 bu = *(const f32x4*)(shb + f0 + 4 * n), bg = *(const f32x4*)(shb + FF + f0 + 4 * n);
                *(LAS f32x4*)(xf + 0 + n * 4) = acc[1][0][2][n] * rs[6] + bu; *(LAS f32x4*)(xf + 8 + n * 4) = acc[1][1][2][n] * rs[6] + bg;
                *(LAS f32x4*)(xf + 16 + n * 4) = acc[1][0][3][n] * rs[7] + bu; *(LAS f32x4*)(xf + 24 + n * 4) = acc[1][1][3][n] * rs[7] + bg;
            }
        }
        asm volatile("s_waitcnt lgkmcnt(0)\n\ts_barrier" ::: "memory");
#pragma unroll
        for (int n = 0; n < 2; ++n) {
            const int fc = f0 + 4 * n;
            const f32x4 bu = *(const f32x4*)(shb + fc), bg = *(const f32x4*)(shb + FF + fc);
            const f32x4 w0u = *(const f32x4*)(cw + fc), w1u = *(const f32x4*)(cw + FF2 + fc), w2u = *(const f32x4*)(cw + 2 * FF2 + fc), cbu = *(const f32x4*)(cb + fc);
            const f32x4 w0g = *(const f32x4*)(cw + FF + fc), w1g = *(const f32x4*)(cw + FF2 + FF + fc), w2g = *(const f32x4*)(cw + 2 * FF2 + FF + fc), cbg = *(const f32x4*)(cb + FF + fc);
            f32x4 p2u, p1u, p2g, p1g;
            {
                const f32x4 u6 = acc[1][0][2][n] * rs[6] + bu, g6 = acc[1][1][2][n] * rs[6] + bg, u7 = acc[1][0][3][n] * rs[7] + bu, g7 = acc[1][1][3][n] * rs[7] + bg;
#pragma unroll
                for (int c = 0; c < 4; ++c) { p2u[c] = __shfl_up(u6[c], 1, 16); p1u[c] = __shfl_up(u7[c], 1, 16); p2g[c] = __shfl_up(g6[c], 1, 16); p1g[c] = __shfl_up(g7[c], 1, 16); }
            }
            if (seqstart) {
                const float* st = cstate + (size_t)(b - 32) * 2 * FF2;
                p2u = *(const f32x4*)(st + fc); p2g = *(const f32x4*)(st + FF + fc); p1u = *(const f32x4*)(st + FF2 + fc); p1g = *(const f32x4*)(st + FF2 + FF + fc);
            } else if (fr == 0 && wr == 1) {
                p2u = *(LAS f32x4*)(xf + 0 + n * 4); p2g = *(LAS f32x4*)(xf + 8 + n * 4); p1u = *(LAS f32x4*)(xf + 16 + n * 4); p1g = *(LAS f32x4*)(xf + 24 + n * 4);
            }
#pragma unroll
            for (int j = 0; j < 8; ++j) {
                const int ai = j >> 2, m = j & 3;
                const f32x4 cu = acc[ai][0][m][n] * rs[j] + bu, cg = acc[ai][1][m][n] * rs[j] + bg;
                if (defer && j < 2) {
                    float* hp = Hfirst + (size_t)(pm * 2 + j) * FF2; *(f32x4*)(hp + fc) = cu; *(f32x4*)(hp + FF + fc) = cg;
                } else {
                    const f32x4 yu = cbu + w0u * p2u + w1u * p1u + w2u * cu, yg = cbg + w0g * p2g + w1g * p1g + w2g * cg;
                    u32x2 w; w.x = pk2(silu_f(yg[0]) * yu[0], silu_f(yg[1]) * yu[1]); w.y = pk2(silu_f(yg[2]) * yu[2], silu_f(yg[3]) * yu[3]);
                    *(u32x2*)(ACT + (size_t)(row0 + j) * FF + fc) = w;
                }
                if (j >= 6) {
                    if (lastlane) { float* hp = Hlast + (size_t)(pm * 2 + (j - 6)) * FF2; *(f32x4*)(hp + fc) = cu; *(f32x4*)(hp + FF + fc) = cg;
                        if ((pm & 7) == 7) { float* cp = ncp + (size_t)((pm >> 3) * 2 + (j - 6)) * FF2; *(f32x4*)(cp + fc) = cu; *(f32x4*)(cp + FF + fc) = cg; } }
                    if (samp && (fr & 3) == 3) { float* cp = ncs + (size_t)((b - 32) * 2 + (j - 6)) * FF2; *(f32x4*)(cp + fc) = cu; *(f32x4*)(cp + FF + fc) = cg; }
                }
                p2u = p1u; p2g = p1g; p1u = cu; p1g = cg;
            }
        }
    }
};

struct EpiDiffIn {
    static constexpr bool PERM = true;
    bf16_t* Qb; bf16_t* Kb; bf16_t* Vb; float* nkp; float* nks; float* nvp; float* nvs; const float* ssq; const float* shW; const float* qg; const float* kg;
    __device__ __forceinline__ void operator()(AccRef acc, const pg8::Unit& u, int wr, int wc, int fr, int fq, LAS unsigned char*) const {
        const int pn = u.pn;
#pragma unroll
        for (int ai = 0; ai < 2; ++ai)
#pragma unroll
            for (int m = 0; m < 4; ++m) {
                const int row = u.pm * 256 + ai * 128 + wr * 64 + m * 16 + fr; const int b = bidx_of(row);
                const float rs = rsqrtf(ssq[row] * (1.f / 1024.f) + EPS);
                const float* shb = shW + (size_t)b * DIN;
                if (pn < 8) {
                    const int cg0 = pn * 256 + wc * 64 + 8 * fq;
                    f32x4 v[2][2]; float ss = 0.f;
#pragma unroll
                    for (int bj = 0; bj < 2; ++bj)
#pragma unroll
                        for (int n = 0; n < 2; ++n) { v[bj][n] = acc[ai][bj][m][n] * rs + *(const f32x4*)(shb + cg0 + 32 * bj + 4 * n);
                            ss += (v[bj][n][0] * v[bj][n][0] + v[bj][n][1] * v[bj][n][1]) + (v[bj][n][2] * v[bj][n][2] + v[bj][n][3] * v[bj][n][3]); }
                    ss += __shfl_xor(ss, 16); ss += __shfl_xor(ss, 32);
                    const float r2 = rsqrtf(ss * (1.f / 64.f) + EPS) * (pn < 4 ? QSCALE : 1.f);
                    const float* gp = (pn < 4 ? qg : kg) + 8 * fq;
#pragma unroll
                    for (int bj = 0; bj < 2; ++bj) {
                        const f32x4 o0 = v[bj][0] * r2 * *(const f32x4*)(gp + 32 * bj), o1 = v[bj][1] * r2 * *(const f32x4*)(gp + 32 * bj + 4);
                        u32x4 w; w.x = pk2(o0[0], o0[1]); w.y = pk2(o0[2], o0[3]); w.z = pk2(o1[0], o1[1]); w.w = pk2(o1[2], o1[3]);
                        const int col = cg0 + 32 * bj;
                        if (pn < 4) *(u32x4*)(Qb + (size_t)row * DM + col) = w;
                        else { const int kc = col - 1024; *(u32x4*)(Kb + (size_t)row * DM + kc) = w;
                            float* op = (row < MP ? nkp + (size_t)row * DM : nks + (size_t)(row - MP) * DM) + kc; *(f32x4*)op = o0; *(f32x4*)(op + 4) = o1; }
                    }
                } else {
#pragma unroll
                    for (int bj = 0; bj < 2; ++bj) {
                        const int col = pn * 256 + bj * 128 + wc * 32 + 8 * fq, vc = col - 2048;
                        const f32x4 o0 = acc[ai][bj][m][0] * rs + *(const f32x4*)(shb + col), o1 = acc[ai][bj][m][1] * rs + *(const f32x4*)(shb + col + 4);
                        u32x4 w; w.x = pk2(o0[0], o0[1]); w.y = pk2(o0[2], o0[3]); w.z = pk2(o1[0], o1[1]); w.w = pk2(o1[2], o1[3]);
                        *(u32x4*)(Vb + (size_t)row * DM + vc) = w;
                        float* op = (row < MP ? nvp + (size_t)row * DM : nvs + (size_t)(row - MP) * DM) + vc; *(f32x4*)op = o0; *(f32x4*)(op + 4) = o1;
                    }
                }
            }
    }
};

__device__ __forceinline__ int slot_col(int mapid, int s) {
    if (mapid == 1) { const int pn = s >> 8, bj = (s >> 7) & 1, r = s & 127; return FF * bj + 128 * pn + r; }
    if (mapid == 2) { if (s >= 2048) return s; const int pn = s >> 8, bj = (s >> 7) & 1, wc = (s >> 5) & 3, l5 = s & 31; return 256 * pn + 64 * wc + 32 * bj + l5; }
    return s;
}
__device__ __forceinline__ void transpose_item(const float* W, int ldw, int nvalid, int K, int nslots, bf16_t* WT, int mapid, LAS float* scr, int item, int lane) {
    const int nblk = nslots / 32, kb = item / nblk, nb = item % nblk, k0 = 64 * kb, s0 = 32 * nb, c0 = slot_col(mapid, s0);
    const int cc = c0 + (lane & 31); const bool ok = cc < nvalid;
#pragma unroll 8
    for (int i = 0; i < 32; ++i) { const int kk = 2 * i + (lane >> 5); scr[kk * 33 + (lane & 31)] = ok ? W[(size_t)(k0 + kk) * ldw + cc] : 0.f; }
    asm volatile("s_waitcnt lgkmcnt(0)" ::: "memory");
    const int c = lane & 7;
#pragma unroll
    for (int j = 0; j < 4; ++j) { const int n = (lane >> 3) + 8 * j; const LAS float* s = scr + (8 * c) * 33 + n;
        u32x4 o; o.x = pk2(s[0 * 33], s[1 * 33]); o.y = pk2(s[2 * 33], s[3 * 33]); o.z = pk2(s[4 * 33], s[5 * 33]); o.w = pk2(s[6 * 33], s[7 * 33]);
        *(u32x4*)(WT + (size_t)(s0 + n) * K + k0 + 8 * c) = o; }
    asm volatile("s_waitcnt lgkmcnt(0)" ::: "memory");
}

template <class ActF>
__device__ __forceinline__ void sg48_item(const float* W, int ldw, int nvalid, const float* bias, float* out, int ldo, int n0, ActF actf, LAS unsigned char* lds) {
    int tid_ = threadIdx.x; asm volatile("" : "+v"(tid_));
    const int tid = tid_, wave = __builtin_amdgcn_readfirstlane(tid >> 6), lane = tid & 63, r = lane & 31, hh = lane >> 5;
    LAS unsigned char* A = lds;
    LAS float* P = (LAS float*)(lds + 99328);
#pragma unroll 4
    for (int it = 0; it < 24; ++it) {
        const int i = tid + 512 * it, b = i >> 8, k4 = (i & 255) * 4;
        const f32x4 v = actf(b, k4);
        *(LAS u32x2*)(A + b * 2064 + k4 * 2) = (u32x2){pk2(v[0], v[1]), pk2(v[2], v[3])};
    }
    for (int i = tid; i < NB * 64; i += 512) P[i] = 0.f;
    __syncthreads();
    f32x16 acc[2][2];
#pragma unroll
    for (int bb = 0; bb < 2; ++bb)
#pragma unroll
        for (int nb = 0; nb < 2; ++nb)
#pragma unroll
            for (int i = 0; i < 16; ++i) acc[bb][nb][i] = 0.f;
    const int kbase = wave * 128;
    int ncol[2]; bool okc[2];
#pragma unroll
    for (int nb = 0; nb < 2; ++nb) { ncol[nb] = n0 + 32 * nb + r; okc[nb] = ncol[nb] < nvalid; if (!okc[nb]) ncol[nb] = 0; }
    const int brow1 = (32 + r < NB) ? 32 + r : NB - 1;
    float wv[2][2][8];
#pragma unroll
    for (int nb = 0; nb < 2; ++nb)
#pragma unroll
        for (int j = 0; j < 8; ++j) wv[0][nb][j] = W[(size_t)(kbase + 8 * hh + j) * ldw + ncol[nb]];
#pragma unroll
    for (int ks = 0; ks < 8; ++ks) {
        if (ks + 1 < 8) {
#pragma unroll
            for (int nb = 0; nb < 2; ++nb)
#pragma unroll
                for (int j = 0; j < 8; ++j) wv[(ks + 1) & 1][nb][j] = W[(size_t)(kbase + 16 * (ks + 1) + 8 * hh + j) * ldw + ncol[nb]];
        }
        const bf16x8 a0 = *(const LAS bf16x8*)(A + r * 2064 + (kbase + 16 * ks + 8 * hh) * 2), a1 = *(const LAS bf16x8*)(A + brow1 * 2064 + (kbase + 16 * ks + 8 * hh) * 2);
#pragma unroll
        for (int nb = 0; nb < 2; ++nb) {
            u32x4 pw;
#pragma unroll
            for (int j = 0; j < 4; ++j) pw[j] = okc[nb] ? pk2(wv[ks & 1][nb][2 * j], wv[ks & 1][nb][2 * j + 1]) : 0u;
            const bf16x8 bw = __builtin_bit_cast(bf16x8, pw);
            acc[0][nb] = MFMA32(a0, bw, acc[0][nb]); acc[1][nb] = MFMA32(a1, bw, acc[1][nb]);
        }
    }
    for (int w8 = 0; w8 < 8; ++w8) {
        if (wave == w8) {
#pragma unroll
            for (int nb = 0; nb < 2; ++nb) {
#pragma unroll
                for (int i = 0; i < 16; ++i) P[crow(i, hh) * 64 + 32 * nb + r] += acc[0][nb][i];
#pragma unroll
                for (int i = 0; i < 8; ++i) P[(32 + crow(i, hh)) * 64 + 32 * nb + r] += acc[1][nb][i];
            }
        }
        __syncthreads();
    }
    for (int i = tid; i < NB * 64; i += 512) { const int b = i >> 6, nn = n0 + (i & 63); if (nn < nvalid) out[(size_t)b * ldo + nn] = P[i] + (bias ? bias[nn] : 0.f); }
    __syncthreads();
}

constexpr int GL_QE = 0, GL_KE = 17408, GL_KDT = 34816, GL_V = 53248, GL_ATT = 90112, GL_ALOW = 99328, GL_BQ = 103424, GL_DEC = 107520, GL_SSQ = 108032, GL_V1 = 110080, GL_ALOW1 = 146944;
__device__ __forceinline__ bf16x8 pack8(const f32x16& x, int s) {
    u32x4 p; p.x = pk2(x[8 * s], x[8 * s + 1]); p.y = pk2(x[8 * s + 2], x[8 * s + 3]); p.z = pk2(x[8 * s + 4], x[8 * s + 5]); p.w = pk2(x[8 * s + 6], x[8 * s + 7]);
    return __builtin_bit_cast(bf16x8, p);
}
__device__ __forceinline__ s16x4 tr_read(LAS unsigned char* p) { return __builtin_bit_cast(s16x4, __builtin_amdgcn_ds_read_tr16_b64_v4i16((LAS v4i16_t*)p)); }
__device__ __forceinline__ bf16x8 cat8(s16x4 lo, s16x4 hi) { return (bf16x8){lo[0], lo[1], lo[2], lo[3], hi[0], hi[1], hi[2], hi[3]}; }

#define LBAR() asm volatile("s_waitcnt lgkmcnt(0)\n\ts_barrier" ::: "memory")
template <int C>
__device__ __forceinline__ void gla_unit(const bf16_t* QKVR, const float* alow, const float* w_alpha, const float* b_alpha, const float* gnorm, bf16_t* O,
                                         int rowbase, int T, int h, const float* S0, float* Sout, LAS unsigned char* lds) {
    constexpr int NTB = C / 32, NKS = C / 16, NE = C / 8;
    int tid_ = threadIdx.x; asm volatile("" : "+v"(tid_));
    const int tid = tid_, lane = tid & 63, w = __builtin_amdgcn_readfirstlane(tid >> 6), r = lane & 31, hh = lane >> 5;
    const int e_lane = 32 * w + r;
    f32x16 S[4];
#pragma unroll
    for (int db = 0; db < 4; ++db)
#pragma unroll
        for (int i = 0; i < 16; ++i) S[db][i] = S0 ? S0[(size_t)(32 * db + crow(i, hh)) * 256 + e_lane] : 0.f;
    const int d0 = 2 * lane, te = w;
    const unsigned lo_v = (unsigned)((tid >> 5) * 3072 + (tid & 31) * 8), lo_q = (unsigned)d0, lo_r = (unsigned)(r * 3072 + 4 * hh), lo_o = (unsigned)(r * 1024 + 4 * hh), lo_a = (unsigned)((tid < C * 4 ? tid : C * 4 - 1) * 4);
    const bool p1act = (te * 8 < C);
    const float bal0 = b_alpha[h * 128 + d0], bal1 = b_alpha[h * 128 + d0 + 1];
    const int ltb = w >> 2, ldb = w & 3;
    const bool lact = (ltb < NTB);
    bf16x8 wbh;
    {
        float wv[8];
#pragma unroll
        for (int j = 0; j < 8; ++j) wv[j] = w_alpha[(8 * hh + j) * 512 + h * 128 + 32 * ldb + r];
        u32x4 ph;
#pragma unroll
        for (int j = 0; j < 4; ++j) ph[j] = pk2(wv[2 * j], wv[2 * j + 1]);
        wbh = __builtin_bit_cast(bf16x8, ph);
    }
    LAS float* BQ = (LAS float*)(lds + GL_BQ); LAS float* DEC = (LAS float*)(lds + GL_DEC); LAS float* SSQ = (LAS float*)(lds + GL_SSQ);
    LAS unsigned char* LG = lds + GL_QE;
    const int nch = T / C;
    if (tid < C * 4) *(LAS f32x4*)(lds + GL_ALOW + tid * 16) = *(const f32x4*)(alow + (size_t)rowbase * 16 + tid * 4);
    for (int i = tid; i < C * 32; i += 512) { const int s = i >> 5, ch = i & 31; *(LAS u32x4*)(lds + GL_V + s * 576 + ch * 16) = *(const u32x4*)(QKVR + (size_t)(rowbase + s) * 3072 + 1024 + h * 256 + ch * 8); }
    unsigned qreg[8], kreg[8];
    if (p1act) {
#pragma unroll
        for (int i = 0; i < 8; ++i) { const bf16_t* qp = QKVR + (size_t)(rowbase + 8 * te + i) * 3072 + h * 128; qreg[i] = *(const unsigned*)(qp + lo_q); kreg[i] = *(const unsigned*)(qp + 512 + lo_q); }
    }
    for (int ci = 0; ci < nch; ++ci) {
        const int row0 = rowbase + ci * C;
        const bool has_next = ci + 1 < nch;
        LAS unsigned char* Vc = lds + ((ci & 1) ? GL_V1 : GL_V); LAS unsigned char* Ac = lds + ((ci & 1) ? GL_ALOW1 : GL_ALOW);
        LBAR();
        u32x4 vn[C / 16]; f32x4 an;
        if (has_next) {
            const int rn = row0 + C;
#pragma unroll
            for (int k = 0; k < C / 16; ++k) { const bf16_t* vp = QKVR + (size_t)(rn + 16 * k) * 3072 + 1024 + h * 256; vn[k] = *(const u32x4*)(vp + lo_v); }
            { const float* apn = alow + (size_t)rn * 16; an = *(const f32x4*)(apn + lo_a); }
        }
        if (lact) {
            const LAS f32x4* ap = (const LAS f32x4*)(Ac + (32 * ltb + r) * 64 + hh * 32);
            const f32x4 a0 = ap[0], a1 = ap[1];
            u32x4 ph, pl;
            ph[0] = pk2(a0[0], a0[1]); ph[1] = pk2(a0[2], a0[3]); ph[2] = pk2(a1[0], a1[1]); ph[3] = pk2(a1[2], a1[3]);
            pl[0] = pk2(a0[0] - bflo(ph[0]), a0[1] - bfhi(ph[0])); pl[1] = pk2(a0[2] - bflo(ph[1]), a0[3] - bfhi(ph[1]));
            pl[2] = pk2(a1[0] - bflo(ph[2]), a1[1] - bfhi(ph[2])); pl[3] = pk2(a1[2] - bflo(ph[3]), a1[3] - bfhi(ph[3]));
            const bf16x8 ah = __builtin_bit_cast(bf16x8, ph), al = __builtin_bit_cast(bf16x8, pl);
            f32x16 lgv;
#pragma unroll
            for (int i = 0; i < 16; ++i) lgv[i] = 0.f;
            lgv = MFMA32(ah, wbh, lgv); lgv = MFMA32(al, wbh, lgv);
#pragma unroll
            for (int i = 0; i < 16; ++i) *(LAS float*)(LG + (32 * ltb + crow(i, hh)) * 528 + (32 * ldb + r) * 4) = lgv[i];
        }
        LBAR();
        float bl0[8], bl1[8]; float run0 = 0.f, run1 = 0.f;
        if (p1act) {
#pragma unroll
            for (int i = 0; i < 8; ++i) {
                const f32x2_t lv = *(const LAS f32x2_t*)(LG + (8 * te + i) * 528 + d0 * 4);
                const float l0 = lv[0] + bal0, l1 = lv[1] + bal1;
                run0 += (fminf(l0, 0.f) - __logf(1.f + __expf(-fabsf(l0)))) * (1.f / 16.f); bl0[i] = run0;
                run1 += (fminf(l1, 0.f) - __logf(1.f + __expf(-fabsf(l1)))) * (1.f / 16.f); bl1[i] = run1;
            }
            *(LAS f32x2_t*)(BQ + te * 128 + d0) = (f32x2_t){run0, run1};
        }
        if (has_next) {
            LAS unsigned char* Vn = lds + (((ci + 1) & 1) ? GL_V1 : GL_V); LAS unsigned char* An = lds + (((ci + 1) & 1) ? GL_ALOW1 : GL_ALOW);
#pragma unroll
            for (int k = 0; k < C / 16; ++k) { const int i = tid + 512 * k, s = i >> 5, ch = i & 31; *(LAS u32x4*)(Vn + s * 576 + ch * 16) = vn[k]; }
            if (tid < C * 4) *(LAS f32x4*)(An + tid * 16) = an;
        }
        LBAR();
        if (p1act) {
            float off0 = 0.f, off1 = 0.f, tot0 = 0.f, tot1 = 0.f;
#pragma unroll
            for (int q2 = 0; q2 < NE; ++q2) { const f32x2_t v = *(const LAS f32x2_t*)(BQ + q2 * 128 + d0); if (q2 < te) { off0 += v[0]; off1 += v[1]; } tot0 += v[0]; tot1 += v[1]; }
            float kd0[8], kd1[8];
#pragma unroll
            for (int i = 0; i < 8; ++i) {
                const int t = 8 * te + i; const float b0 = bl0[i] + off0, b1 = bl1[i] + off1;
                const float q0 = bflo(qreg[i]), q1 = bfhi(qreg[i]), k0 = bflo(kreg[i]), k1 = bfhi(kreg[i]);
                *(LAS unsigned*)(lds + GL_QE + t * 272 + d0 * 2) = pk2(q0 * GLA_QSC * __expf(b0), q1 * GLA_QSC * __expf(b1));
                *(LAS unsigned*)(lds + GL_KE + t * 272 + d0 * 2) = pk2(k0 * __expf(-b0), k1 * __expf(-b1));
                kd0[i] = k0 * __expf(tot0 - b0); kd1[i] = k1 * __expf(tot1 - b1);
            }
            *(LAS u32x4*)(lds + GL_KDT + d0 * 144 + te * 16) = (u32x4){pk2(kd0[0], kd0[1]), pk2(kd0[2], kd0[3]), pk2(kd0[4], kd0[5]), pk2(kd0[6], kd0[7])};
            *(LAS u32x4*)(lds + GL_KDT + (d0 + 1) * 144 + te * 16) = (u32x4){pk2(kd1[0], kd1[1]), pk2(kd1[2], kd1[3]), pk2(kd1[4], kd1[5]), pk2(kd1[6], kd1[7])};
            if (te == 0) *(LAS f32x2_t*)(DEC + d0) = (f32x2_t){__expf(tot0), __expf(tot1)};
        }
        LBAR();
        if (w < (NTB == 2 ? 3 : 1)) {
            const int sb = (w == 2) ? 1 : 0, tb = (w == 0) ? 0 : 1;
            f32x16 a;
#pragma unroll
            for (int i = 0; i < 16; ++i) a[i] = 0.f;
#pragma unroll
            for (int ks = 0; ks < 8; ++ks) {
                const bf16x8 A = *(const LAS bf16x8*)(lds + GL_KE + (32 * sb + r) * 272 + (16 * ks + 8 * hh) * 2);
                const bf16x8 B = *(const LAS bf16x8*)(lds + GL_QE + (32 * tb + r) * 272 + (16 * ks + 8 * hh) * 2);
                a = MFMA32(A, B, a);
            }
            const int t = 32 * tb + r;
#pragma unroll
            for (int g = 0; g < 4; ++g) {
                const int sbase = 32 * sb + 8 * g + 4 * hh;
                const float v0 = (sbase + 0 <= t) ? a[4 * g + 0] : 0.f, v1 = (sbase + 1 <= t) ? a[4 * g + 1] : 0.f, v2 = (sbase + 2 <= t) ? a[4 * g + 2] : 0.f, v3 = (sbase + 3 <= t) ? a[4 * g + 3] : 0.f;
                *(LAS u32x2*)(lds + GL_ATT + t * 144 + sbase * 2) = (u32x2){pk2(v0, v1), pk2(v2, v3)};
            }
        }
        f32x16 o[NTB];
#pragma unroll
        for (int tb = 0; tb < NTB; ++tb)
#pragma unroll
            for (int i = 0; i < 16; ++i) o[tb][i] = 0.f;
#pragma unroll
        for (int db = 0; db < 4; ++db)
#pragma unroll
            for (int s2 = 0; s2 < 2; ++s2) {
                const bf16x8 A = pack8(S[db], s2);
#pragma unroll
                for (int tb = 0; tb < NTB; ++tb) {
                    LAS unsigned char* qb = lds + GL_QE + (32 * tb + r) * 272 + (32 * db + 16 * s2 + 4 * hh) * 2;
                    const s16x4 lo = *(const LAS s16x4*)qb, hi = *(const LAS s16x4*)(qb + 16);
                    o[tb] = MFMA32(A, cat8(lo, hi), o[tb]);
                }
                __builtin_amdgcn_sched_barrier(0);
            }
        LBAR();
        u32x2 rg[NTB][4];
#pragma unroll
        for (int tb = 0; tb < NTB; ++tb)
#pragma unroll
            for (int g = 0; g < 4; ++g) { const bf16_t* rp = QKVR + (size_t)(row0 + 32 * tb) * 3072 + 2048 + h * 256 + 32 * w + 8 * g; rg[tb][g] = *(const u32x2*)(rp + lo_r); }
        bf16x8 vf[NKS];
#pragma unroll
        for (int ks = 0; ks < NKS; ++ks) {
            LAS unsigned char* vb = Vc + (16 * ks + 8 * hh + ((lane & 15) >> 2)) * 576 + (32 * w + 16 * ((lane >> 4) & 1) + 4 * (lane & 3)) * 2;
            vf[ks] = cat8(tr_read(vb), tr_read(vb + 4 * 576));
        }
#pragma unroll
        for (int tb = 0; tb < NTB; ++tb)
#pragma unroll
            for (int ks = 0; ks < NKS; ++ks) {
                if (tb == 0 && ks >= 2) continue;
                const bf16x8 B = *(const LAS bf16x8*)(lds + GL_ATT + (32 * tb + r) * 144 + (16 * ks + 8 * hh) * 2);
                o[tb] = MFMA32(vf[ks], B, o[tb]);
            }
#pragma unroll
        for (int db = 0; db < 4; ++db) {
#pragma unroll
            for (int g = 0; g < 4; ++g) { const f32x4 dc = *(const LAS f32x4*)(DEC + 32 * db + 8 * g + 4 * hh);
                S[db][4 * g] *= dc[0]; S[db][4 * g + 1] *= dc[1]; S[db][4 * g + 2] *= dc[2]; S[db][4 * g + 3] *= dc[3]; }
#pragma unroll
            for (int ks = 0; ks < NKS; ++ks) {
                const bf16x8 A = *(const LAS bf16x8*)(lds + GL_KDT + (32 * db + r) * 144 + (16 * ks + 8 * hh) * 2);
                S[db] = MFMA32(A, vf[ks], S[db]);
            }
            __builtin_amdgcn_sched_barrier(0);
        }
#pragma unroll
        for (int tb = 0; tb < NTB; ++tb) {
            float q = 0.f;
#pragma unroll
            for (int i = 0; i < 16; ++i) q += o[tb][i] * o[tb][i];
            q += __shfl_xor(q, 32);
            if (hh == 0) SSQ[w * 64 + 32 * tb + r] = q;
        }
        LBAR();
        if (has_next) {
            const int rn = row0 + C;
            int l2_ = threadIdx.x; asm volatile("" : "+v"(l2_)); const unsigned lo_q2 = 2u * (unsigned)(l2_ & 63);
            if (p1act) {
#pragma unroll
                for (int i = 0; i < 8; ++i) { const bf16_t* qp = QKVR + (size_t)(rn + 8 * te + i) * 3072 + h * 128; qreg[i] = *(const unsigned*)(qp + lo_q2); kreg[i] = *(const unsigned*)(qp + 512 + lo_q2); }
            }
        }
#pragma unroll
        for (int tb = 0; tb < NTB; ++tb) {
            const int t = 32 * tb + r;
            float tot = 0.f;
#pragma unroll
            for (int w2 = 0; w2 < 8; ++w2) tot += SSQ[w2 * 64 + t];
            const float rs = rsqrtf(tot * (1.f / 256.f) + EPS);
#pragma unroll
            for (int g = 0; g < 4; ++g) {
                const int e0 = 32 * w + 8 * g + 4 * hh;
                const f32x4 gnv = *(const f32x4*)(gnorm + 32 * w + 8 * g + (unsigned)(4 * hh));
                const u32x2 rr = rg[tb][g];
                const float y0 = o[tb][4 * g] * rs * gnv[0] * silu_f(bflo(rr.x)), y1 = o[tb][4 * g + 1] * rs * gnv[1] * silu_f(bfhi(rr.x));
                const float y2 = o[tb][4 * g + 2] * rs * gnv[2] * silu_f(bflo(rr.y)), y3 = o[tb][4 * g + 3] * rs * gnv[3] * silu_f(bfhi(rr.y));
                { bf16_t* op = O + (size_t)(row0 + 32 * tb) * DM + h * 256 + 32 * w + 8 * g; *(u32x2*)(op + lo_o) = (u32x2){pk2(y0, y1), pk2(y2, y3)}; }
            }
        }
    }
    {
        int t2 = threadIdx.x; asm volatile("" : "+v"(t2));
        const unsigned lo_s = (unsigned)(4 * ((t2 & 63) >> 5) * 256 + 32 * (t2 >> 6) + (t2 & 31));
#pragma unroll
        for (int db = 0; db < 4; ++db)
#pragma unroll
            for (int i = 0; i < 16; ++i) { float* sp = Sout + (size_t)(32 * db + (i & 3) + 8 * (i >> 2)) * 256; sp[lo_s] = S[db][i]; }
    }
    __syncthreads();
}

constexpr int AT_X = 36864;
struct AttnSrc { const bf16_t* Qb; const bf16_t* Kb; const bf16_t* Vb; const bf16_t* KC; const bf16_t* VC; bf16_t* O; const float* dnorm; };

__device__ __forceinline__ void attn_unit(const AttnSrc& A, int grp, int b, int h, int qb, float lam, LAS unsigned char* lds) {
    int tid_ = threadIdx.x; asm volatile("" : "+v"(tid_));
    const int tid = tid_, lane = tid & 63, w = __builtin_amdgcn_readfirstlane(tid >> 6), r = lane & 31, hh = lane >> 5;
    const int c = w & 1, rb = w >> 1;
    const int rowbase = grp == 0 ? b * 2048 : MP + b * 32;
    const int p0 = grp == 0 ? 128 * qb : 0;
    const int NT = grp == 0 ? 2 * qb + 2 : 33;
    const bool active = grp == 0 ? true : (rb == 0);
    const int my_last = grp == 0 ? 2 * qb + (rb >> 1) : 32;
    bf16x8 qf[4];
    {
        const bf16_t* Qw = A.Qb + (size_t)(rowbase + p0 + (active ? 32 * rb : 0) + r) * DM + h * 128 + c * 64 + 8 * hh;
#pragma unroll
        for (int ks = 0; ks < 4; ++ks) qf[ks] = *(const bf16x8*)(Qw + 16 * ks);
    }
    f32x16 Oa[4];
#pragma unroll
    for (int d = 0; d < 4; ++d)
#pragma unroll
        for (int i = 0; i < 16; ++i) Oa[d][i] = 0.f;
    float m_run = 0.f, lsum = 0.f;
    u32x4 kreg[2], vreg[2];
#define LOAD_TILE(t_) do { _Pragma("unroll") for (int i_ = 0; i_ < 2; ++i_) { \
            const int id_ = tid + 512 * i_, row_ = id_ >> 4, ch_ = id_ & 15, key_ = 64 * (t_) + row_; \
            const bf16_t* kp_; const bf16_t* vp_; bool ok_ = true; \
            if (grp == 0) { const size_t o_ = (size_t)(rowbase + key_) * DM + h * 128 + ch_ * 8; kp_ = A.Kb + o_; vp_ = A.Vb + o_; } \
            else if (key_ < 2048) { const size_t o_ = (size_t)(b * 2048 + key_) * DM + h * 128 + ch_ * 8; kp_ = A.KC + o_; vp_ = A.VC + o_; } \
            else { ok_ = key_ < 2080; const size_t o_ = (size_t)(rowbase + (ok_ ? key_ - 2048 : 0)) * DM + h * 128 + ch_ * 8; kp_ = A.Kb + o_; vp_ = A.Vb + o_; } \
            kreg[i_] = *(const u32x4*)kp_; vreg[i_] = *(const u32x4*)vp_; \
            if (!ok_) { kreg[i_] = (u32x4){0u, 0u, 0u, 0u}; vreg[i_] = (u32x4){0u, 0u, 0u, 0u}; } } } while (0)
#define LOAD_TILE2(t_) do { _Pragma("unroll") for (int i_ = 0; i_ < 2; ++i_) { \
            const int id_ = tid + 512 * i_, row_ = id_ >> 4, ch_ = id_ & 15, key_ = 64 * (t_) + row_; \
            const bf16_t* kp_; const bf16_t* vp_; bool ok_ = true; \
            if (grp == 0) { const size_t o_ = (size_t)(rowbase + key_) * DM + h * 128 + ch_ * 8; kp_ = A.Kb + o_; vp_ = A.Vb + o_; } \
            else if (key_ < 2048) { const size_t o_ = (size_t)(b * 2048 + key_) * DM + h * 128 + ch_ * 8; kp_ = A.KC + o_; vp_ = A.VC + o_; } \
            else { ok_ = key_ < 2080; const size_t o_ = (size_t)(rowbase + (ok_ ? key_ - 2048 : 0)) * DM + h * 128 + ch_ * 8; kp_ = A.Kb + o_; vp_ = A.Vb + o_; } \
            k2[i_] = *(const u32x4*)kp_; v2[i_] = *(const u32x4*)vp_; \
            if (!ok_) { k2[i_] = (u32x4){0u, 0u, 0u, 0u}; v2[i_] = (u32x4){0u, 0u, 0u, 0u}; } } } while (0)
    LOAD_TILE(0);
    const bool grpB = (w >= 4);
    bf16x8 pw[4];
#define QK_SOFTMAX(t_) do { \
        LAS unsigned char* Kt = lds + ((t_) % 3) * 32768; \
        f32x16 s0, s1; \
        _Pragma("unroll") for (int i = 0; i < 16; ++i) { s0[i] = 0.f; s1[i] = 0.f; } \
        _Pragma("unroll") for (int ks = 0; ks < 4; ++ks) { \
            const int chx = ((8 * c + 2 * ks + hh) ^ (r & 15)) * 16; \
            const bf16x8 a0 = *(const LAS bf16x8*)(Kt + r * 256 + chx), a1 = *(const LAS bf16x8*)(Kt + (32 + r) * 256 + chx); \
            s0 = MFMA32(a0, qf[ks], s0); s1 = MFMA32(a1, qf[ks], s1); } \
        if (grp == 1 && (t_) == 32) { _Pragma("unroll") for (int i = 0; i < 16; ++i) s1[i] = -1e30f; } \
          \
          \
        float ps = 0.f; \
        _Pragma("unroll") for (int i = 0; i < 16; ++i) { s0[i] = __builtin_amdgcn_exp2f(s0[i]); s1[i] = __builtin_amdgcn_exp2f(s1[i]); ps += s0[i] + s1[i]; } \
        lsum += ps; \
        pw[0] = pack8(s0, 0); pw[1] = pack8(s0, 1); pw[2] = pack8(s1, 0); pw[3] = pack8(s1, 1); \
    } while (0)
#define PV_STEP(t_) do { \
        LAS unsigned char* Vt = lds + ((t_) % 3) * 32768 + 16384; \
        const int i4 = (lane >> 2) & 3, p = lane & 3, g16 = (lane >> 4) & 1; \
        _Pragma("unroll") for (int bs = 0; bs < 4; ++bs) { \
            const int k0 = 16 * bs + 4 * hh; \
            _Pragma("unroll") for (int d = 0; d < 4; ++d) { \
                const int chv = ((4 * d + 2 * g16 + (p >> 1)) ^ (4 * i4)) * 16 + 8 * (p & 1); \
                const s16x4 lo = tr_read(Vt + (k0 + i4) * 256 + chv), hi = tr_read(Vt + (k0 + 8 + i4) * 256 + chv); \
                Oa[d] = MFMA32(cat8(lo, hi), pw[bs], Oa[d]); } } \
    } while (0)
#define SAMPLE_STEP(t_, S2_) do { \
        LAS unsigned char* Kt = lds + ((t_) % 3) * 32768; LAS unsigned char* Vt = Kt + 16384; \
        f32x16 sv; \
        _Pragma("unroll") for (int i = 0; i < 16; ++i) sv[i] = 0.f; \
        _Pragma("unroll") for (int ks = 0; ks < 4; ++ks) { \
            const int chx = ((8 * c + 2 * ks + hh) ^ (r & 15)) * 16; \
            const bf16x8 a0 = *(const LAS bf16x8*)(Kt + (32 * sblk + r) * 256 + chx); \
            sv = MFMA32(a0, qf[ks], sv); } \
        float ps = 0.f; \
        _Pragma("unroll") for (int j = 0; j < 8; ++j) { sv[8 * (S2_) + j] = __builtin_amdgcn_exp2f(sv[8 * (S2_) + j]); ps += sv[8 * (S2_) + j]; } \
        lsum += ps; \
        const bf16x8 pwv = pack8(sv, (S2_)); \
        const int i4 = (lane >> 2) & 3, p = lane & 3, g16 = (lane >> 4) & 1; \
        const int k0 = 16 * (2 * sblk + (S2_)) + 4 * hh; \
        _Pragma("unroll") for (int d = 0; d < 4; ++d) { \
            const int chv = ((4 * d + 2 * g16 + (p >> 1)) ^ (4 * i4)) * 16 + 8 * (p & 1); \
            const s16x4 lo = tr_read(Vt + (k0 + i4) * 256 + chv), hi = tr_read(Vt + (k0 + 8 + i4) * 256 + chv); \
            Oa[d] = MFMA32(cat8(lo, hi), pwv, Oa[d]); } \
    } while (0)
    if (grp == 1) {
        const int sblk = rb >> 1;
        u32x4 k2[2], v2[2];
        LOAD_TILE2(1);
#define SAMPLE_ITER(t_, KR, VR, LD) do { \
            const int tt = (t_); \
            LAS unsigned char* Kt = lds + (tt % 3) * 32768; LAS unsigned char* Vt = Kt + 16384; \
            _Pragma("unroll") for (int i = 0; i < 2; ++i) { \
                const int id = tid + 512 * i, row = id >> 4, ch = id & 15; \
                *(LAS u32x4*)(Kt + row * 256 + ((ch ^ (row & 15)) * 16)) = KR[i]; \
                *(LAS u32x4*)(Vt + row * 256 + ((ch ^ (4 * (row & 3))) * 16)) = VR[i]; } \
            asm volatile("s_waitcnt lgkmcnt(0)\n\ts_barrier" ::: "memory"); \
            if (tt + 2 < NT) LD(tt + 2); \
            if (!(tt == 32 && sblk == 1)) { if (rb & 1) SAMPLE_STEP(tt, 1); else SAMPLE_STEP(tt, 0); } \
        } while (0)
        for (int t = 0; t < NT; t += 2) {
            SAMPLE_ITER(t, kreg, vreg, LOAD_TILE);
            if (t + 1 < NT) SAMPLE_ITER(t + 1, k2, v2, LOAD_TILE2);
        }
        __syncthreads();
        {
            const float lw = lsum + __shfl_xor(lsum, 32);
            LAS float* Pw = (LAS float*)(lds + w * 16384);
#pragma unroll
            for (int d = 0; d < 4; ++d)
#pragma unroll
                for (int i = 0; i < 16; ++i) Pw[(d * 16 + i) * 64 + lane] = Oa[d][i];
            ((LAS float*)(lds + 131072 + w * 256))[lane] = lw;
            __syncthreads();
            if (rb == 0) {
                float lt = lw;
#pragma unroll
                for (int rb2 = 1; rb2 < 4; ++rb2) {
                    const LAS float* P2 = (const LAS float*)(lds + (2 * rb2 + c) * 16384);
#pragma unroll
                    for (int d = 0; d < 4; ++d)
#pragma unroll
                        for (int i = 0; i < 16; ++i) Oa[d][i] += P2[(d * 16 + i) * 64 + lane];
                    lt += ((const LAS float*)(lds + 131072 + (2 * rb2 + c) * 256))[lane];
                }
                lsum = 0.5f * lt;
            }
        }
    } else {
    for (int t = 0; t <= NT; ++t) {
        if (t < NT) {
            LAS unsigned char* Kt = lds + (t % 3) * 32768; LAS unsigned char* Vt = Kt + 16384;
#pragma unroll
            for (int i = 0; i < 2; ++i) {
                const int id = tid + 512 * i, row = id >> 4, ch = id & 15;
                *(LAS u32x4*)(Kt + row * 256 + ((ch ^ (row & 15)) * 16)) = kreg[i];
                *(LAS u32x4*)(Vt + row * 256 + ((ch ^ (4 * (row & 3))) * 16)) = vreg[i];
            }
        }
        __syncthreads();
        if (t + 1 < NT) LOAD_TILE(t + 1);
        const bool doqk = active && t < NT && t <= my_last;
        if (active && grpB && t >= 1 && t - 1 <= my_last) PV_STEP(t - 1);
        if (doqk) QK_SOFTMAX(t);
        if (doqk && !grpB) PV_STEP(t);
    }
    }
    __syncthreads();
    lsum += __shfl_xor(lsum, 32);
    const float inv = active ? 1.f / lsum : 0.f;
    LAS float* X = (LAS float*)(lds + AT_X + rb * 16384);
    if (active && c == 1) {
#pragma unroll
        for (int d = 0; d < 4; ++d)
#pragma unroll
            for (int i = 0; i < 16; ++i) X[(d * 16 + i) * 64 + lane] = Oa[d][i] * inv;
    }
    __syncthreads();
    if (active && c == 0) {
        float q = 0.f;
#pragma unroll
        for (int d = 0; d < 4; ++d)
#pragma unroll
            for (int i = 0; i < 16; ++i) { const float v = Oa[d][i] * inv - lam * X[(d * 16 + i) * 64 + lane]; Oa[d][i] = v; q += v * v; }
        q += __shfl_xor(q, 32);
        const float rs = rsqrtf(q * (1.f / 128.f) + EPS) * (1.f - LAM_INIT1);
        LAS unsigned char* OT = lds + rb * 8704;
#pragma unroll
        for (int d = 0; d < 4; ++d)
#pragma unroll
            for (int g = 0; g < 4; ++g) {
                const int dv = 32 * d + 8 * g + 4 * hh; const f32x4 gnv = *(const f32x4*)(A.dnorm + dv);
                *(LAS u32x2*)(OT + r * 272 + dv * 2) = (u32x2){pk2(Oa[d][4 * g] * rs * gnv[0], Oa[d][4 * g + 1] * rs * gnv[1]), pk2(Oa[d][4 * g + 2] * rs * gnv[2], Oa[d][4 * g + 3] * rs * gnv[3])};
            }
        asm volatile("s_waitcnt lgkmcnt(0)" ::: "memory");
#pragma unroll
        for (int k = 0; k < 8; ++k) {
            const int id = lane + 64 * k, row = id >> 4, ch = id & 15;
            const u32x4 v = *(const LAS u32x4*)(OT + row * 272 + ch * 16);
            *(u32x4*)(A.O + (size_t)(rowbase + p0 + 32 * rb + row) * DM + h * 128 + ch * 8) = v;
        }
    }
    __syncthreads();
}

#ifndef REP_P0
#define REP_P0 1
#endif
#ifndef REP_P2
#define REP_P2 1
#endif
#ifndef REP_G
#define REP_G 1
#endif
#ifndef REP_U
#define REP_U 1
#endif
#ifndef REP_A
#define REP_A 1
#endif
struct Args { const float* in[27]; float* out; unsigned char* ws; };
enum { I_XP = 0, I_XS, I_SGLA, I_CK, I_CV, I_SCONV, I_CP, I_CS, I_NMIX, I_NFFN, I_WADA, I_BADA, I_GWIN, I_GWAL, I_GBAL, I_GNORM, I_GWOUT, I_DWIN, I_DQN, I_DKN, I_DLAM, I_DNORM, I_DWOUT, I_FWIN, I_FCW, I_FCB, I_FWOUT };

#define XB_TMO      128
#define XB_XCNT(j)  (256  + 64 * (j))
#define XB_XSUB(j)  (1280 + 64 * (j))
#define XB_XGEN(j)  (2304 + 64 * (j))
#define XB_TOP      3328
#define XB_TOPGEN   3392
#define XCD_BAR_WORDS 3456
#define XB_SPIN_CAP (1u << 18)

__device__ __forceinline__ unsigned xb_ld(unsigned* p)              { return __hip_atomic_load(p, __ATOMIC_RELAXED, __HIP_MEMORY_SCOPE_AGENT); }
__device__ __forceinline__ unsigned xb_add(unsigned* p, unsigned v) { return __hip_atomic_fetch_add(p, v, __ATOMIC_RELAXED, __HIP_MEMORY_SCOPE_AGENT); }
__device__ __forceinline__ unsigned xb_xcc_id() { return (unsigned)__builtin_amdgcn_s_getreg((3 << 11) | 20) & 0xFu; }
#define XB_SPIN(cond, bar) do { unsigned _sp = 0; while (cond) { __builtin_amdgcn_s_sleep(1); \
    if ((++_sp & 255u) == 0u) { if (xb_ld(&(bar)[XB_TMO])) break; if (_sp > XB_SPIN_CAP) { atomicAdd(&(bar)[XB_TMO], 1u); break; } } } } while (0)

struct XcdBarrier {
    unsigned* bar; unsigned x;
    volatile LAS unsigned* st;
};

__device__ __forceinline__ XcdBarrier xcd_barrier_post(unsigned* bar, volatile LAS unsigned* st) {
    XcdBarrier b; b.bar = bar; b.x = xb_xcc_id(); b.st = st;
    if (threadIdx.x == 0) (void)xb_add(&bar[XB_XCNT(b.x)], 1u);
    return b;
}
__device__ __forceinline__ void xcd_barrier_complete(unsigned* bar, unsigned x, unsigned& nloc, unsigned& nx) {
    const unsigned G = gridDim.x * gridDim.y * gridDim.z;
    unsigned sum, cnt, mine, sp = 0u;
    for (;;) {
        sum = 0u; cnt = 0u; mine = 0u;
#pragma unroll
        for (unsigned j = 0; j < 16; ++j) { const unsigned c = xb_ld(&bar[XB_XCNT(j)]); sum += c; cnt += (c > 0u) ? 1u : 0u; mine = (j == x) ? c : mine; }
        if (sum == G) break;
        __builtin_amdgcn_s_sleep(1);
        if ((++sp & 255u) == 0u) { if (xb_ld(&bar[XB_TMO])) break; if (sp > XB_SPIN_CAP) { atomicAdd(&bar[XB_TMO], 1u); break; } }
    }
    nloc = mine > 0u ? mine : 1u; nx = cnt > 0u ? cnt : 1u;
}

__device__ __forceinline__ void xcd_barrier(const XcdBarrier& b) {
    asm volatile("s_waitcnt vmcnt(0)" ::: "memory");
    __syncthreads();
    if (threadIdx.x == 0) {
        unsigned* bar = b.bar;
        __builtin_amdgcn_s_waitcnt(0);
        unsigned nloc = b.st[0], nx = b.st[1];
        if (nloc == 0u) { xcd_barrier_complete(bar, b.x, nloc, nx); b.st[0] = nloc; b.st[1] = nx; }
        const unsigned old = xb_add(&bar[XB_XSUB(b.x)], 1u);
        const unsigned gen = old / nloc;
        if (old + 1u == (gen + 1u) * nloc) {
            __builtin_amdgcn_fence(__ATOMIC_RELEASE, "agent");
            asm volatile("s_waitcnt vmcnt(0)" ::: "memory");
            const unsigned og = xb_add(&bar[XB_TOP], 1u);
            const unsigned tg = og / nx;
            if (og + 1u == (tg + 1u) * nx) xb_add(&bar[XB_TOPGEN], 1u);
            else XB_SPIN(xb_ld(&bar[XB_TOPGEN]) == tg, bar);
            __builtin_amdgcn_fence(__ATOMIC_ACQUIRE, "agent");
            xb_add(&bar[XB_XGEN(b.x)], 1u);
            asm volatile("s_waitcnt vmcnt(0)" ::: "memory");
        } else {
            XB_SPIN(xb_ld(&bar[XB_XGEN(b.x)]) == gen, bar);
            __builtin_amdgcn_fence(__ATOMIC_ACQUIRE, "agent");
            asm volatile("s_waitcnt vmcnt(0)" ::: "memory");
        }
    }
    __syncthreads();
}

__device__ __forceinline__ unsigned long long ldp(LAS unsigned long long* PT, int i) {
    const unsigned long long v = PT[i];
    const unsigned lo = __builtin_amdgcn_readfirstlane((unsigned)v), hi = __builtin_amdgcn_readfirstlane((unsigned)(v >> 32));
    return ((unsigned long long)hi << 32) | lo;
}
__device__ __forceinline__ void ffn_fixup(const pg8::StaticOrder& S, bf16_t* ACT, const float* Hfirst, const float* Hlast, const float* cw, const float* cb) {
    pg8::Unit u; int lastpm = -1;
    int t_ = threadIdx.x; asm volatile("" : "+v"(t_));
    for (int i = 0; S.next(i, u); ++i) {
        const int pm = u.pm; if (pm >= 256 || pm == lastpm) continue; lastpm = pm;
        const bool first = (pm & 7) == 0;
        const float* hl = Hlast + (size_t)((first ? pm : pm - 1) * 2) * FF2;
        const float* hf = Hfirst + (size_t)(pm * 2) * FF2;
        bf16_t* ab = ACT + (size_t)(pm * 256) * FF;
        for (unsigned f = (unsigned)t_; f < (unsigned)FF; f += 512u) {
            float yu[2], yg[2];
#pragma unroll
            for (int ug = 0; ug < 2; ++ug) {
                const unsigned col = (unsigned)(ug * FF) + f;
                const float P6 = first ? 0.f : hl[col], P7 = first ? 0.f : hl[FF2 + col];
                const float F0 = hf[col], F1 = hf[FF2 + col];
                const float w0 = cw[col], w1 = cw[FF2 + col], w2 = cw[2 * FF2 + col], bb = cb[col];
                const float y0 = bb + w0 * P6 + w1 * P7 + w2 * F0, y1 = bb + w0 * P7 + w1 * F0 + w2 * F1;
                if (ug == 0) { yu[0] = y0; yu[1] = y1; } else { yg[0] = y0; yg[1] = y1; }
            }
            ab[f] = f2bf(silu_f(yg[0]) * yu[0]);
            ab[FF + f] = f2bf(silu_f(yg[1]) * yu[1]);
        }
    }
    asm volatile("s_waitcnt vmcnt(0)" ::: "memory");
    __syncthreads();
}

__global__ void __launch_bounds__(512, 2) fwd(Args a) {
    extern __shared__ __attribute__((aligned(16))) unsigned char lds_[];
    LAS unsigned char* lds = (LAS unsigned char*)lds_;
    cg::grid_group grid = cg::this_grid();
    const int tid = threadIdx.x, lane = tid & 63, wave = __builtin_amdgcn_readfirstlane(tid >> 6);
    const int G = gridDim.x, bx = blockIdx.x;
    const int gw = bx * 8 + wave, NGW = G * 8;
    LAS unsigned long long* PT = (LAS unsigned long long*)(lds + PT_OFF);
    if (tid == 0) {
#pragma unroll
        for (int i = 0; i < 27; ++i) PT[i] = (unsigned long long)a.in[i];
        PT[27] = (unsigned long long)a.out; PT[28] = (unsigned long long)a.ws; PT[29] = (unsigned long long)(a.ws + WS_BAR);
        ((LAS unsigned*)(lds + PT_OFF + 240))[0] = 0u; ((LAS unsigned*)(lds + PT_OFF + 240))[1] = 0u;
    }
    __syncthreads();
    volatile LAS unsigned* xst = (volatile LAS unsigned*)(lds + PT_OFF + 240);
    (void)xcd_barrier_post((unsigned*)(a.ws + WS_BAR), xst);
#define GRID_SYNC() do { XcdBarrier b_; b_.bar = (unsigned*)ldp(PT, 29); b_.x = xb_xcc_id(); b_.st = xst; xcd_barrier(b_); } while (0)
#define GAS __attribute__((address_space(1)))
#define IN(i) ((const float*)(GAS const float*)ldp(PT, (i)))
#define OUTP ((float*)(GAS float*)ldp(PT, 27))
#define WSP(T, off) ((T*)(GAS T*)((GAS unsigned char*)ldp(PT, 28) + (off)))
#define mod WSP(float, WS_MOD)
#define shW WSP(float, WS_SHW)
#define ssq0 WSP(float, WS_SSQ)
#define ssq1 (WSP(float, WS_SSQ) + MTOT)
#define ssq2 (WSP(float, WS_SSQ) + 2 * MTOT)
#define ssq3 (WSP(float, WS_SSQ) + 3 * MTOT)
#define alow WSP(float, WS_ALOW)
#define Hf WSP(float, WS_HF)
#define Hl WSP(float, WS_HL)
#define Wgi WSP(bf16_t, WS_WGI)
#define Wgo WSP(bf16_t, WS_WGO)
#define Wdi WSP(bf16_t, WS_WDI)
#define Wdo WSP(bf16_t, WS_WDO)
#define WU(l) WSP(bf16_t, (l) == 0 ? WS_WU0 : WS_WU1)
#define WD(l) WSP(bf16_t, (l) == 0 ? WS_WD0 : WS_WD1)
#define XM WSP(bf16_t, WS_XM)
#define OB WSP(bf16_t, WS_O)
#define QKVR WSP(bf16_t, WS_QKVR)
#define ACT WSP(bf16_t, WS_QKVR)
#define KC WSP(bf16_t, WS_KC)
#define VC WSP(bf16_t, WS_VC)
#define out OUTP
#define mod0 mod
#define mod1 (mod + (size_t)NB * MODW)

    for (int rep_ = 0; rep_ < REP_P0; ++rep_)
    {
        for (int i = bx * 512 + tid; i < 3 * MTOT; i += G * 512) ssq1[i] = 0.f;
        LAS float* scr = (LAS float*)(lds + wave * 16384);
        for (int it = gw; it < 16 * 104; it += NGW) transpose_item(IN(I_GWIN), GIN, GIN, 1024, GIN_PAD, Wgi, 0, scr, it, lane);
        __syncthreads();
        const float* cp = IN(I_CP); const float* cs = IN(I_CS);
        for (int it = bx; it < 2 * 96; it += G) {
            const int layer = it / 96, cb = it % 96;
            sg48_item(IN(I_WADA) + (size_t)layer * 1024 * MODW, MODW, MODW, IN(I_BADA) + layer * MODW, mod + (size_t)layer * NB * MODW, MODW, 64 * cb,
                      [&](int b, int k) { const f32x4 c = *(const f32x4*)(b < 32 ? cp + b * 1024 + k : cs + (b - 32) * 1024 + k); return (f32x4){silu_f(c[0]), silu_f(c[1]), silu_f(c[2]), silu_f(c[3])}; }, lds);
        }
    }
    grid.sync();
    for (int rep_ = 0; rep_ < REP_P0; ++rep_)
    {
        for (int it = bx; it < 49; it += G) { const float* sh = mod; sg48_item(IN(I_GWIN), GIN, GIN, nullptr, shW + SHW_GLA, GIN_PAD, 64 * it, [&](int b, int k) { return *(const f32x4*)(sh + (size_t)b * MODW + k); }, lds); }
        const float* gain = IN(I_NMIX); const float* xp_ = IN(I_XP); const float* xs_ = IN(I_XS); const float* mod_ = mod; bf16_t* xm_ = XM; float* ssq0_ = ssq0;
        for (int row0_ = gw; row0_ < MTOT; row0_ += 2 * NGW) {
            f32x4 v[2][4]; const float* scp[2];
#pragma unroll
            for (int q = 0; q < 2; ++q) {
                const int row = (row0_ + q * NGW < MTOT) ? row0_ + q * NGW : row0_;
                const float* xr = row < MP ? xp_ + (size_t)row * DM : xs_ + (size_t)(row - MP) * DM;
                scp[q] = mod_ + (size_t)bidx_of(row) * MODW + 1024;
#pragma unroll
                for (int j = 0; j < 4; ++j) v[q][j] = *(const f32x4*)(xr + 4 * lane + 256 * j);
            }
#pragma unroll
            for (int q = 0; q < 2; ++q) {
                const int row = row0_ + q * NGW;
                if (row < MTOT) {
                    float s1 = 0.f;
#pragma unroll
                    for (int j = 0; j < 4; ++j) s1 += (v[q][j][0] * v[q][j][0] + v[q][j][1] * v[q][j][1]) + (v[q][j][2] * v[q][j][2] + v[q][j][3] * v[q][j][3]);
                    s1 = wave_sum(s1);
                    if (lane == 0) ssq0_[row] = s1;
#pragma unroll
                    for (int j = 0; j < 4; ++j) { const int col = 4 * lane + 256 * j; const f32x4 s = *(const f32x4*)(gain + col) * (*(const f32x4*)(scp[q] + col) + 1.f); const f32x4 z = v[q][j] * s;
                        *(u32x2*)(xm_ + (size_t)row * DM + col) = (u32x2){pk2(z[0], z[1]), pk2(z[2], z[3])}; }
                }
            }
        }
    }
    GRID_SYNC();
    for (int rep_ = 0; rep_ < REP_G; ++rep_)
    {
        pg8::Gemm g{XM, Wgi, MTOT, GIN_PAD, 1024}; pg8::StaticOrder S; S.init(MTOT, GIN_PAD, G, bx);
        EpiGlaIn E{QKVR, alow, ssq0, shW + SHW_GLA};
        pg8::gemm_phase<EpiGlaIn, pg8::StaticOrder, true, true, false>(lds, g, S, E, lds + XL_OFF);
    }
    GRID_SYNC();
    for (int rep_ = 0; rep_ < REP_P2; ++rep_)
    {
        if (bx < 128) { const int b = bx >> 2, h = bx & 3;
            gla_unit<64>(QKVR, alow, IN(I_GWAL), IN(I_GBAL), IN(I_GNORM), OB, b * 2048, 2048, h, nullptr, out + O_GSP + (size_t)(b * 4 + h) * 128 * 256, lds);
        } else if (bx < 192) { const int b = (bx - 128) >> 2, h = bx & 3;
            gla_unit<32>(QKVR, alow, IN(I_GWAL), IN(I_GBAL), IN(I_GNORM), OB, MP + b * 32, 32, h, IN(I_SGLA) + (size_t)(b * 4 + h) * 128 * 256, out + O_GSS + (size_t)(b * 4 + h) * 128 * 256, lds);
        }
        if (bx >= 128) {
            const int aw = bx - 128, NAW = G - 128;
            LAS float* scr = (LAS float*)(lds + wave * 16384);
            constexpr int I1 = 16 * 32, I2 = 16 * 96, I3 = 16 * 32, I4 = 16 * 176, I5 = 44 * 32;
            constexpr int NIT = I1 + I2 + I3 + 2 * I4 + 2 * I5;
            for (int it = aw * 8 + wave; it < NIT; it += NAW * 8) {
                int r = it;
                if (r < I1) { transpose_item(IN(I_GWOUT), 1024, 1024, 1024, 1024, Wgo, 0, scr, r, lane); continue; } r -= I1;
                if (r < I2) { transpose_item(IN(I_DWIN), DIN, DIN, 1024, DIN, Wdi, 2, scr, r, lane); continue; } r -= I2;
                if (r < I3) { transpose_item(IN(I_DWOUT), 1024, 1024, 1024, 1024, Wdo, 0, scr, r, lane); continue; } r -= I3;
                if (r < I4) { transpose_item(IN(I_FWIN), FF2, FF2, 1024, FF2, WU(0), 1, scr, r, lane); continue; } r -= I4;
                if (r < I4) { transpose_item(IN(I_FWIN) + (size_t)1024 * FF2, FF2, FF2, 1024, FF2, WU(1), 1, scr, r, lane); continue; } r -= I4;
                if (r < I5) { transpose_item(IN(I_FWOUT), 1024, 1024, FF, 1024, WD(0), 0, scr, r, lane); continue; } r -= I5;
                transpose_item(IN(I_FWOUT) + (size_t)FF * 1024, 1024, 1024, FF, 1024, WD(1), 0, scr, r, lane);
            }
            __syncthreads();
            for (int it = aw; it < 88 + 48 + 88; it += NAW) {
                int r = it;
                if (r < 88) { const float* sh = mod + 3072; sg48_item(IN(I_FWIN), FF2, FF2, nullptr, shW + SHW_UP0, FF2, 64 * r, [&](int b, int k) { return *(const f32x4*)(sh + (size_t)b * MODW + k); }, lds); continue; } r -= 88;
                if (r < 48) { const float* sh = mod + (size_t)NB * MODW; sg48_item(IN(I_DWIN), DIN, DIN, nullptr, shW + SHW_DIF, DIN, 64 * r, [&](int b, int k) { return *(const f32x4*)(sh + (size_t)b * MODW + k); }, lds); continue; } r -= 48;
                { const float* sh = mod + (size_t)NB * MODW + 3072; sg48_item(IN(I_FWIN) + (size_t)1024 * FF2, FF2, FF2, nullptr, shW + SHW_UP1, FF2, 64 * r, [&](int b, int k) { return *(const f32x4*)(sh + (size_t)b * MODW + k); }, lds); }
            }
            const size_t NCH = (size_t)16 * 2048 * 1024 / 8;
            for (int kv = 0; kv < 2; ++kv) {
                const float* srcb = kv ? IN(I_CV) : IN(I_CK); bf16_t* dstb = kv ? VC : KC;
                const size_t step = (size_t)NAW * 512;
                for (size_t i = (size_t)aw * 512 + tid; i < NCH; i += 4 * step) {
                    f32x4 x0[4], x1[4];
#pragma unroll
                    for (int q = 0; q < 4; ++q) { const size_t j = i + q * step; const float* src = srcb + (j < NCH ? j : i) * 8; x0[q] = *(const f32x4*)src; x1[q] = *(const f32x4*)(src + 4); }
#pragma unroll
                    for (int q = 0; q < 4; ++q) { const size_t j = i + q * step; if (j < NCH) *(u32x4*)(dstb + j * 8) = (u32x4){pk2(x0[q][0], x0[q][1]), pk2(x0[q][2], x0[q][3]), pk2(x1[q][0], x1[q][1]), pk2(x1[q][2], x1[q][3])}; }
                }
            }
        }
    }
    GRID_SYNC();
    {
        pg8::Gemm g{OB, Wgo, MP, 1024, 1024}; pg8::StaticOrder S; S.init(MP, 1024, G, bx);
        EpiRes E{IN(I_XP), IN(I_XS), out + O_Y, XM, ssq1, mod0 + 2048, mod0 + 4096, IN(I_NFFN), 0};
        for (int it = bx; it < 256; it += G) thin_res_item(OB, Wgo, 1024, it, E);
        pg8::gemm_phase<EpiRes, pg8::StaticOrder, true, true, false>(lds, g, S, E, lds + XL_OFF);
    }
    GRID_SYNC();
    {
        const float* modl = 0 == 0 ? mod0 : mod1;
        const float* cw = IN(I_FCW) + (size_t)0 * 3 * FF2; const float* cb = IN(I_FCB) + (size_t)0 * FF2;
    for (int rep_ = 0; rep_ < REP_U; ++rep_)
        {
            pg8::Gemm g{XM, WU(0), MTOT, FF2, 1024}; pg8::StaticOrder S; S.init(MTOT, FF2, G, bx);
            EpiUp E{ACT, Hf, Hl, 0 == 0 ? ssq1 : ssq3, shW + (0 == 0 ? SHW_UP0 : SHW_UP1), cw, cb, IN(I_SCONV) + (size_t)0 * 16 * 2 * FF2,
                    out + O_CP + (size_t)0 * 32 * 2 * FF2, out + O_CS + (size_t)0 * 16 * 2 * FF2};
            pg8::gemm_phase<EpiUp, pg8::StaticOrder, true, true, true>(lds, g, S, E, lds + XL_OFF);
        }
        GRID_SYNC();
        {
            pg8::Gemm g{ACT, WD(0), MP, 1024, FF}; pg8::StaticOrder S; S.init(MP, 1024, G, bx);
            ffn_fixup(S, ACT, Hf, Hl, cw, cb);
            EpiRes E{out + O_Y, out + O_Y + (size_t)MP * DM, out + O_Y, XM, ssq2, modl + 5120, mod1 + 1024, IN(I_NMIX) + 1024, 0};
            for (int it = bx; it < 256; it += G) thin_res_item(ACT, WD(0), FF, it, E);
            pg8::gemm_phase<EpiRes, pg8::StaticOrder, true, true, false>(lds, g, S, E, lds + XL_OFF);
        }
        GRID_SYNC();
    for (int rep_ = 0; rep_ < REP_G; ++rep_)
        {
            pg8::Gemm g{XM, Wdi, MTOT, DIN, 1024}; pg8::StaticOrder S; S.init(MTOT, DIN, G, bx);
            EpiDiffIn E{QKVR, QKVR + (size_t)MTOT * DM, QKVR + (size_t)2 * MTOT * DM, out + O_KP, out + O_KS, out + O_VP, out + O_VS, ssq2, shW + SHW_DIF, IN(I_DQN), IN(I_DKN)};
            pg8::gemm_phase<EpiDiffIn, pg8::StaticOrder, true, true, false>(lds, g, S, E, lds + XL_OFF);
        }
        GRID_SYNC();
    for (int rep_ = 0; rep_ < REP_A; ++rep_)
        {
            const float* dl = IN(I_DLAM);
            const float s1 = wave_sum(dl[lane] * dl[64 + lane]), s2 = wave_sum(dl[128 + lane] * dl[192 + lane]);
            const float lam = __expf(s1) - __expf(s2) + LAM_INIT1;
            AttnSrc A{QKVR, QKVR + (size_t)MTOT * DM, QKVR + (size_t)2 * MTOT * DM, KC, VC, OB, IN(I_DNORM)};
            const int vcu = (G % 8 == 0) ? (bx & 7) * (G >> 3) + (bx >> 3) : bx;
            for (int pi = vcu; pi < 2048; pi += G) {
                const int bh = pi >> 3, s = pi & 7;
                attn_unit(A, 0, bh >> 3, bh & 7, s, lam, lds);
                attn_unit(A, 0, bh >> 3, bh & 7, 15 - s, lam, lds);
            }
            for (int su = bx; su < 128; su += G) attn_unit(A, 1, su >> 3, su & 7, 0, lam, lds);
        }
        GRID_SYNC();
        {
            pg8::Gemm g{OB, Wdo, MP, 1024, 1024}; pg8::StaticOrder S; S.init(MP, 1024, G, bx);
            EpiRes E{out + O_Y, out + O_Y + (size_t)MP * DM, out + O_Y, XM, ssq3, mod1 + 2048, mod1 + 4096, IN(I_NFFN) + 1024, 0};
            for (int it = bx; it < 256; it += G) thin_res_item(OB, Wdo, 1024, it, E);
            pg8::gemm_phase<EpiRes, pg8::StaticOrder, true, true, false>(lds, g, S, E, lds + XL_OFF);
        }
        GRID_SYNC();
    }
    {
        const float* modl = 1 == 0 ? mod0 : mod1;
        const float* cw = IN(I_FCW) + (size_t)1 * 3 * FF2; const float* cb = IN(I_FCB) + (size_t)1 * FF2;
    for (int rep_ = 0; rep_ < 1; ++rep_)
        {
            pg8::Gemm g{XM, WU(1), MTOT, FF2, 1024}; pg8::StaticOrder S; S.init(MTOT, FF2, G, bx);
            EpiUp E{ACT, Hf, Hl, 1 == 0 ? ssq1 : ssq3, shW + (1 == 0 ? SHW_UP0 : SHW_UP1), cw, cb, IN(I_SCONV) + (size_t)1 * 16 * 2 * FF2,
                    out + O_CP + (size_t)1 * 32 * 2 * FF2, out + O_CS + (size_t)1 * 16 * 2 * FF2};
            pg8::gemm_phase<EpiUp, pg8::StaticOrder, true, true, true>(lds, g, S, E, lds + XL_OFF);
        }
        GRID_SYNC();
        {
            pg8::Gemm g{ACT, WD(1), MP, 1024, FF}; pg8::StaticOrder S; S.init(MP, 1024, G, bx);
            ffn_fixup(S, ACT, Hf, Hl, cw, cb);
            EpiRes E{out + O_Y, out + O_Y + (size_t)MP * DM, out + O_Y, XM, ssq2, modl + 5120, mod1 + 1024, IN(I_NMIX) + 1024, 1};
            for (int it = bx; it < 256; it += G) thin_res_item(ACT, WD(1), FF, it, E);
            pg8::gemm_phase<EpiRes, pg8::StaticOrder, true, true, false>(lds, g, S, E, lds + XL_OFF);
        }
    }
}

#undef out
#undef mod
extern "C" void kernel_launch(void* const* d_in, const int* in_sizes, int n_in, void* d_out, int out_size, void* d_ws, size_t ws_size, hipStream_t stream) {
    static int inited = 0;
    if (!inited) {
        (void)hipFuncSetAttribute((const void*)fwd, hipFuncAttributeMaxDynamicSharedMemorySize, LDS_BYTES);
        int per_cu = 0; (void)hipOccupancyMaxActiveBlocksPerMultiprocessor(&per_cu, (const void*)fwd, 512, LDS_BYTES);
        if (n_in != 27 || ws_size < WS_END || per_cu < 1) fprintf(stderr, "kernel_launch: n_in %d ws %zu per_cu %d out %d\n", n_in, ws_size, per_cu, out_size);
        inited = 1;
    }
    Args a{};
    for (int i = 0; i < 27; ++i) a.in[i] = (const float*)d_in[i];
    a.out = (float*)d_out; a.ws = (unsigned char*)d_ws;
    (void)hipMemsetAsync((unsigned char*)d_ws + WS_BAR, 0, 16384, stream);
    void* args[] = {&a};
    hipError_t e = hipLaunchCooperativeKernel((const void*)fwd, dim3(256), dim3(512), args, LDS_BYTES, stream);
    if (e != hipSuccess) fprintf(stderr, "cooperative launch failed: %s\n", hipGetErrorString(e));
}
```

```cpp
#include <hip/hip_runtime.h>
#include <hip/hip_cooperative_groups.h>
#include <cstdint>
#include <cstdio>
namespace cg = cooperative_groups;

#define LAS __attribute__((address_space(3)))
typedef short s16x4 __attribute__((ext_vector_type(4)));
typedef float f32x16 __attribute__((ext_vector_type(16)));
typedef unsigned u32x2 __attribute__((ext_vector_type(2)));
typedef float f32x2_t __attribute__((ext_vector_type(2)));
typedef __bf16 bf16x2_t __attribute__((ext_vector_type(2)));
typedef short v4i16_t __attribute__((ext_vector_type(4)));

constexpr int DM = 1024, MP = 65536, MS = 512, MTOT = MP + MS, NB = 48;
constexpr int GIN = 3088, GIN_PAD = 3328, FF = 2816, FF2 = 5632, DIN = 3072, MODW = 6144;
constexpr float EPS = 1e-6f;
constexpr float LAM_INIT1 = 0.35550906759f;
constexpr float QSCALE = 0.125f * 1.4426950408889634f;
constexpr float GLA_QSC = 0.08838834764831845f;

constexpr size_t O_Y = 0, O_GSP = 67633152, O_GSS = 71827456, O_KP = 73924608, O_KS = 141033472, O_VP = 141557760, O_VS = 208666624, O_CP = 209190912, O_CS = 209911808;

constexpr size_t MiB = 1u << 20;
constexpr size_t WS_BAR = 2621440;
constexpr size_t WS_MOD = 0, WS_SHW = 3 * MiB, WS_SSQ = 7 * MiB, WS_ALOW = 9 * MiB, WS_HF = 14 * MiB, WS_HL = 26 * MiB;
constexpr size_t WS_WGI = 38 * MiB, WS_WGO = 45 * MiB, WS_WDI = 47 * MiB, WS_WDO = 53 * MiB, WS_WU0 = 55 * MiB, WS_WU1 = 66 * MiB, WS_WD0 = 77 * MiB, WS_WD1 = 83 * MiB;
constexpr size_t WS_XM = 90 * MiB, WS_O = 220 * MiB, WS_QKVR = 350 * MiB, WS_KC = 738 * MiB, WS_VC = 802 * MiB, WS_END = 866 * MiB;
constexpr size_t SHW_GLA = 0, SHW_UP0 = (size_t)NB * GIN_PAD, SHW_DIF = SHW_UP0 + (size_t)NB * FF2, SHW_UP1 = SHW_DIF + (size_t)NB * DIN;

constexpr int XL_OFF = 131072;
constexpr int LDS_BYTES = 163840;
constexpr int PT_OFF = 163584;

__device__ __forceinline__ unsigned pk2(float lo, float hi) { f32x2_t v = {lo, hi}; bf16x2_t b = __builtin_convertvector(v, bf16x2_t); return __builtin_bit_cast(unsigned, b); }
__device__ __forceinline__ float bflo(unsigned u) { return __uint_as_float(u << 16); }
__device__ __forceinline__ float bfhi(unsigned u) { return __uint_as_float(u & 0xffff0000u); }
__device__ __forceinline__ float bf2f(unsigned short u) { return __uint_as_float(((unsigned)u) << 16); }
__device__ __forceinline__ unsigned short f2bf(float f) { return (unsigned short)(pk2(f, 0.f) & 0xffffu); }
__device__ __forceinline__ float silu_f(float x) { return x * __builtin_amdgcn_rcpf(1.f + __expf(-x)); }
__device__ __forceinline__ int bidx_of(int row) { return row < MP ? (row >> 11) : 32 + ((row - MP) >> 5); }
__device__ __forceinline__ int crow(int r, int hi) { return (r & 3) + 8 * (r >> 2) + 4 * hi; }
__device__ __forceinline__ float wave_sum(float v) {
#pragma unroll
    for (int o = 1; o < 64; o <<= 1) v += __shfl_xor(v, o);
    return v;
}
#define MFMA32(a, b, c) __builtin_amdgcn_mfma_f32_32x32x16_bf16((a), (b), (c), 0, 0, 0)

namespace pg8 {
#define PG8_LAS __attribute__((address_space(3)))
typedef unsigned short bf16_t;
typedef short bf16x8 __attribute__((ext_vector_type(8)));
typedef float f32x4 __attribute__((ext_vector_type(4)));
typedef unsigned u32x4 __attribute__((ext_vector_type(4)));
constexpr int BM = 256, BK = 64, HALF = 128, HTB = HALF * BK * 2  , STAGE_BYTES = 8 * HTB, NXCD = 8, WGM = 8;

__host__ __device__ __forceinline__ int lds_byte(int r, int c) { const int st = (r >> 4) * 2 + (c >> 5), rr = r & 15, cc = c & 31, ob = rr * 64 + cc * 2; return st * 1024 + (ob ^ (((ob >> 9) & 1) << 5)); }
__host__ __device__ __forceinline__ void stage_rc(int b, int& R, int& C) { const int st = b / 1024, sb = b % 1024, swz = sb ^ (((sb >> 9) & 1) << 5); R = (st >> 1) * 16 + swz / 64; C = (st & 1) * 32 + (swz % 64) / 2; }
__host__ __device__ __forceinline__ int perm32(int rho) { const int n = rho >> 4, i = rho & 15; return 8 * (i >> 2) + 4 * n + (i & 3); }

struct Unit { int pm, pn; };
struct Gemm { const bf16_t* A; const bf16_t* Bt; int M, N, K; };

struct StaticOrder {
    int nM, nN, nwg, G, c;
    __host__ __device__ void init(int M, int N, int G_, int c_) { nM = M / BM; nN = N / BM; nwg = nM * nN; G = G_; c = c_; }
    __host__ __device__ bool next(int i, Unit& u) const {
        const long L = (long)i * G + c; if (L >= nwg) return false;
        int wgid = (int)L; { const int q = nwg / NXCD, r = nwg % NXCD, xcd = wgid % NXCD, off = wgid / NXCD; wgid = (xcd < r ? xcd * (q + 1) : r * (q + 1) + (xcd - r) * q) + off; }
        const int nig = WGM * nN, gid = wgid / nig, fm = gid * WGM, gsz = (nM - fm) < WGM ? (nM - fm) : WGM;
        u.pm = fm + ((wgid % nig) % gsz); u.pn = (wgid % nig) / gsz; return true;
    }
    __device__ __forceinline__ void a_ready(const Unit&) const {}
    __device__ __forceinline__ void done(const Unit&) const {}
};

template <class Epi, class Sched, bool ALIGN_EPI, bool SP2, bool ROWPERM>
__device__ __forceinline__ void gemm_phase(PG8_LAS unsigned char* lds, const Gemm g, const Sched& S, const Epi& E, PG8_LAS unsigned char* xl) {
    int tid_ = threadIdx.x; asm volatile("" : "+v"(tid_));
    const int tid = tid_, wid = __builtin_amdgcn_readfirstlane(tid >> 6), lane = tid & 63, wr = wid >> 2, wc = wid & 3, fr = lane & 15, fq = lane >> 4;
    const int K = g.K, nt = K / BK;
    unsigned voffA[2], voffB[2];
#pragma unroll
    for (int i = 0; i < 2; ++i) { int R, C; stage_rc(tid * 16 + i * 8192, R, C); const int Rb = Epi::PERM ? ((R & ~31) + perm32(R & 31)) : R;
        const int Ra = ROWPERM ? (((R >> 6) & 1) * 128 + (R & 15) * 8 + ((R >> 4) & 3)) : R;
        voffA[i] = (unsigned)(Ra * K + C) * 2u; voffB[i] = (unsigned)(Rb * K + C) * 2u; }
    const size_t kstep = (size_t)(BK * 2);
    const size_t hstep = (size_t)HALF * K * 2; const size_t hstepA = ROWPERM ? (size_t)4 * K * 2 : hstep;
    const size_t tstep = 2 * hstep;
    const unsigned ldsw = (unsigned)wid * 1024u;
    const int aoff = lds_byte(wr * 64 + fr, fq * 8), boff = lds_byte(wc * 32 + fr, fq * 8);
#define PG8_SA(b, h) (((b) * 2 + (h)) * HTB)
#define PG8_SB(b, h) ((4 + (b) * 2 + (h)) * HTB)
#define PG8_STAGE(bufoff, gbase, voff) do { _Pragma("unroll") for (int _i = 0; _i < 2; ++_i) \
        __builtin_amdgcn_global_load_lds((const unsigned*)((const char*)(gbase) + (voff)[_i]), (PG8_LAS unsigned*)(lds + (bufoff) + ldsw + _i * 8192), 16, 0, 0); } while (0)
#define PG8_LDA(dst, b, h) do { _Pragma("unroll") for (int m = 0; m < 4; ++m) _Pragma("unroll") for (int k = 0; k < 2; ++k) dst[m][k] = *(const PG8_LAS bf16x8*)(lds + PG8_SA(b, h) + aoff + m * 2048 + k * 1024); } while (0)
#define PG8_LDB(dst, b, h) do { _Pragma("unroll") for (int n = 0; n < 2; ++n) _Pragma("unroll") for (int k = 0; k < 2; ++k) dst[n][k] = *(const PG8_LAS bf16x8*)(lds + PG8_SB(b, h) + boff + n * 2048 + k * 1024); } while (0)
#define PG8_MMA(ai, bj, At, Bt) do { __builtin_amdgcn_s_setprio(1); _Pragma("unroll") for (int m = 0; m < 4; ++m) _Pragma("unroll") for (int n = 0; n < 2; ++n) _Pragma("unroll") for (int k = 0; k < 2; ++k) \
        acc[ai][bj][m][n] = __builtin_amdgcn_mfma_f32_16x16x32_bf16(Bt[n][k], At[m][k], acc[ai][bj][m][n], 0, 0, 0); __builtin_amdgcn_s_setprio(0); } while (0)
#define PG8_WAIT_V(n) asm volatile("s_waitcnt vmcnt(" #n ")" ::: "memory")
#define PG8_WAIT_L(n) asm volatile("s_waitcnt lgkmcnt(" #n ")" ::: "memory")
#define PG8_BAR __builtin_amdgcn_s_barrier()
#define PG8_SCHED __builtin_amdgcn_sched_barrier(0)
    Unit cur, nxt; int ui = 0;
    if (!S.next(0, cur)) return;
    f32x4 acc[2][2][4][2];
#pragma unroll
    for (int a = 0; a < 2; ++a)
#pragma unroll
        for (int b = 0; b < 2; ++b)
#pragma unroll
            for (int m = 0; m < 4; ++m)
#pragma unroll
                for (int n = 0; n < 2; ++n) acc[a][b][m][n] = (f32x4){0.f, 0.f, 0.f, 0.f};
    bf16x8 At[4][2], B0[2][2], B1[2][2];
    const char* cA = (const char*)g.A + (size_t)cur.pm * tstep; const char* cB = (const char*)g.Bt + (size_t)cur.pn * tstep;

    if constexpr (SP2) {
        PG8_STAGE(PG8_SB(0, 0), cB, voffB); PG8_STAGE(PG8_SB(0, 1), cB + hstep, voffB); PG8_STAGE(PG8_SA(0, 0), cA, voffA); PG8_STAGE(PG8_SA(0, 1), cA + hstepA, voffA);
        if (wr == 1) PG8_BAR;
        PG8_WAIT_V(2); PG8_BAR;
        PG8_STAGE(PG8_SB(1, 0), cB + kstep, voffB); PG8_STAGE(PG8_SA(1, 0), cA + kstep, voffA); PG8_STAGE(PG8_SB(1, 1), cB + hstep + kstep, voffB);
        PG8_WAIT_V(6); PG8_BAR;
    } else {
        PG8_STAGE(PG8_SB(0, 0), cB, voffB); PG8_STAGE(PG8_SA(0, 0), cA, voffA); PG8_STAGE(PG8_SB(0, 1), cB + hstep, voffB); PG8_STAGE(PG8_SA(0, 1), cA + hstepA, voffA);
        if (wr == 1) PG8_BAR;
        PG8_WAIT_V(4); PG8_BAR;
        PG8_STAGE(PG8_SB(1, 0), cB + kstep, voffB); PG8_STAGE(PG8_SA(1, 0), cA + kstep, voffA); PG8_STAGE(PG8_SB(1, 1), cB + hstep + kstep, voffB);
        PG8_WAIT_V(6); PG8_BAR;
    }
    for (;;) {
        const bool has_next = S.next(ui + 1, nxt);
        const char* nA = has_next ? (const char*)g.A + (size_t)nxt.pm * tstep : cA; const char* nB = has_next ? (const char*)g.Bt + (size_t)nxt.pn * tstep : cB;
        for (int t = 0; t < nt; t += 2) {
            const bool last = (t == nt - 2);
            const char* a1 = cA + (size_t)(t + 1) * kstep;
            const char* a2 = last ? nA : cA + (size_t)(t + 2) * kstep; const char* b2 = last ? nB : cB + (size_t)(t + 2) * kstep;
            const char* a3 = a2 + kstep; const char* b3 = b2 + kstep;

            if constexpr (SP2) {
            PG8_LDB(B0, 0, 0); PG8_LDB(B1, 0, 1); PG8_SCHED; PG8_LDA(At, 0, 0); PG8_STAGE(PG8_SA(1, 1), a1 + hstepA, voffA);
            PG8_WAIT_V(8); PG8_WAIT_L(0); PG8_BAR; PG8_MMA(0, 0, At, B0); PG8_MMA(0, 1, At, B1); PG8_BAR; PG8_SCHED;
            PG8_LDA(At, 0, 1); PG8_STAGE(PG8_SB(0, 0), b2, voffB); PG8_STAGE(PG8_SB(0, 1), b2 + hstep, voffB); PG8_STAGE(PG8_SA(0, 0), a2, voffA);
            PG8_WAIT_V(8); PG8_WAIT_L(0); PG8_BAR; PG8_MMA(1, 0, At, B0); PG8_MMA(1, 1, At, B1); PG8_BAR; PG8_SCHED;
            PG8_LDB(B0, 1, 0); PG8_LDB(B1, 1, 1); PG8_SCHED; PG8_LDA(At, 1, 0); PG8_STAGE(PG8_SA(0, 1), a2 + hstepA, voffA);
            PG8_WAIT_V(8); PG8_WAIT_L(0); PG8_BAR; PG8_MMA(0, 0, At, B0); PG8_MMA(0, 1, At, B1); PG8_BAR; PG8_SCHED;
            PG8_LDA(At, 1, 1); PG8_STAGE(PG8_SB(1, 0), b3, voffB); PG8_STAGE(PG8_SB(1, 1), b3 + hstep, voffB); PG8_STAGE(PG8_SA(1, 0), a3, voffA);
            PG8_WAIT_V(8); PG8_WAIT_L(0); PG8_BAR; PG8_MMA(1, 0, At, B0); PG8_MMA(1, 1, At, B1); PG8_BAR; PG8_SCHED;
            } else {
            PG8_LDB(B0, 0, 0); PG8_SCHED; PG8_LDA(At, 0, 0); PG8_STAGE(PG8_SA(1, 1), a1 + hstepA, voffA);
            PG8_WAIT_L(8); PG8_BAR; PG8_WAIT_L(0); PG8_MMA(0, 0, At, B0); PG8_BAR; PG8_SCHED;
            PG8_LDB(B1, 0, 1); PG8_STAGE(PG8_SB(0, 0), b2, voffB);
            PG8_BAR; PG8_WAIT_L(0); PG8_MMA(0, 1, At, B1); PG8_BAR;
            PG8_LDA(At, 0, 1); PG8_STAGE(PG8_SA(0, 0), a2, voffA);
            PG8_BAR; PG8_WAIT_L(0); PG8_MMA(1, 0, At, B0); PG8_BAR; PG8_SCHED;
            PG8_STAGE(PG8_SB(0, 1), b2 + hstep, voffB);
            PG8_WAIT_V(6); PG8_BAR; PG8_MMA(1, 1, At, B1); PG8_BAR;
            PG8_LDB(B0, 1, 0); PG8_SCHED; PG8_LDA(At, 1, 0); PG8_STAGE(PG8_SA(0, 1), a2 + hstepA, voffA);
            PG8_WAIT_L(8); PG8_BAR; PG8_WAIT_L(0); PG8_MMA(0, 0, At, B0); PG8_BAR; PG8_SCHED;
            PG8_LDB(B1, 1, 1); PG8_STAGE(PG8_SB(1, 0), b3, voffB);
            PG8_BAR; PG8_WAIT_L(0); PG8_MMA(0, 1, At, B1); PG8_BAR;
            PG8_LDA(At, 1, 1); PG8_STAGE(PG8_SA(1, 0), a3, voffA);
            PG8_BAR; PG8_WAIT_L(0); PG8_MMA(1, 0, At, B0); PG8_BAR; PG8_SCHED;
            PG8_STAGE(PG8_SB(1, 1), b3 + hstep, voffB);
            PG8_WAIT_V(6); PG8_BAR; PG8_MMA(1, 1, At, B1); PG8_BAR;
            }
        }
        if constexpr (ALIGN_EPI) { if (wr == 0) PG8_BAR; }
        E(acc, cur, wr, wc, fr, fq, xl);
        if (!has_next) break;
#pragma unroll
        for (int a = 0; a < 2; ++a)
#pragma unroll
            for (int b = 0; b < 2; ++b)
#pragma unroll
                for (int m = 0; m < 4; ++m)
#pragma unroll
                    for (int n = 0; n < 2; ++n) acc[a][b][m][n] = (f32x4){0.f, 0.f, 0.f, 0.f};
        cur = nxt; cA = nA; cB = nB; ++ui;
        if constexpr (ALIGN_EPI) { if (wr == 1) PG8_BAR; }
    }
    PG8_WAIT_V(0);
    if constexpr (!ALIGN_EPI) { if (wr == 0) PG8_BAR; }
    PG8_BAR;
#undef PG8_SA
#undef PG8_SB
#undef PG8_STAGE
#undef PG8_LDA
#undef PG8_LDB
#undef PG8_MMA
#undef PG8_WAIT_V
#undef PG8_WAIT_L
#undef PG8_BAR
#undef PG8_SCHED
}
}

using pg8::bf16_t; using pg8::bf16x8; using pg8::f32x4; using pg8::u32x4;
typedef const f32x4 (&AccRef)[2][2][4][2];

struct EpiGlaIn {
    static constexpr bool PERM = true;
    bf16_t* QKVR; float* alow; const float* ssq; const float* shW;
    __device__ __forceinline__ void operator()(AccRef acc, const pg8::Unit& u, int wr, int wc, int fr, int fq, LAS unsigned char*) const {
        const int colt = u.pn * 256 + wc * 32 + 8 * fq;
#pragma unroll
        for (int ai = 0; ai < 2; ++ai)
#pragma unroll
            for (int m = 0; m < 4; ++m) {
                const int row = u.pm * 256 + ai * 128 + wr * 64 + m * 16 + fr; const int b = bidx_of(row);
                const float rs = rsqrtf(ssq[row] * (1.f / 1024.f) + EPS);
#pragma unroll
                for (int bj = 0; bj < 2; ++bj) {
                    const int col = colt + bj * 128;
                    const f32x4 b0 = *(const f32x4*)(shW + (size_t)b * GIN_PAD + col), b1 = *(const f32x4*)(shW + (size_t)b * GIN_PAD + col + 4);
                    const f32x4 v0 = acc[ai][bj][m][0] * rs + b0, v1 = acc[ai][bj][m][1] * rs + b1;
                    if (u.pn < 12) { u32x4 w; w.x = pk2(v0[0], v0[1]); w.y = pk2(v0[2], v0[3]); w.z = pk2(v1[0], v1[1]); w.w = pk2(v1[2], v1[3]); *(u32x4*)(QKVR + (size_t)row * 3072 + col) = w; }
                    else if (col < GIN) { float* p = alow + (size_t)row * 16 + (col - 3072); *(f32x4*)p = v0; *(f32x4*)(p + 4) = v1; }
                }
            }
    }
};

struct EpiRes {
    static constexpr bool PERM = true;
    const float* xin_p; const float* xin_s; float* xout; bf16_t* XM; float* ssq_out; const float* gt; const float* sc; const float* gain; int last;
    __device__ __forceinline__ void operator()(AccRef acc, const pg8::Unit& u, int wr, int wc, int fr, int fq, LAS unsigned char*) const {
        const int colt = u.pn * 256 + wc * 32 + 8 * fq;
#pragma unroll
        for (int ai = 0; ai < 2; ++ai)
#pragma unroll
            for (int m = 0; m < 4; ++m) {
                const int row = u.pm * 256 + ai * 128 + wr * 64 + m * 16 + fr; const int b = bidx_of(row);
                const float* xin = row < MP ? xin_p + (size_t)row * DM : xin_s + (size_t)(row - MP) * DM;
                float ss = 0.f;
#pragma unroll
                for (int bj = 0; bj < 2; ++bj) {
                    const int col = colt + bj * 128;
                    const f32x4 g0 = *(const f32x4*)(gt + (size_t)b * MODW + col), g1 = *(const f32x4*)(gt + (size_t)b * MODW + col + 4);
                    const f32x4 x0 = *(const f32x4*)(xin + col), x1 = *(const f32x4*)(xin + col + 4);
                    const f32x4 y0 = x0 + g0 * acc[ai][bj][m][0], y1 = x1 + g1 * acc[ai][bj][m][1];
                    float* op = xout + (size_t)row * DM + col;
                    if (last) { __builtin_nontemporal_store(y0, (f32x4*)op); __builtin_nontemporal_store(y1, (f32x4*)(op + 4)); } else { *(f32x4*)op = y0; *(f32x4*)(op + 4) = y1; }
                    if (!last) {
                        const f32x4 s0 = *(const f32x4*)(gain + col) * (*(const f32x4*)(sc + (size_t)b * MODW + col) + 1.f), s1 = *(const f32x4*)(gain + col + 4) * (*(const f32x4*)(sc + (size_t)b * MODW + col + 4) + 1.f);
                        const f32x4 z0 = y0 * s0, z1 = y1 * s1;
                        u32x4 w; w.x = pk2(z0[0], z0[1]); w.y = pk2(z0[2], z0[3]); w.z = pk2(z1[0], z1[1]); w.w = pk2(z1[2], z1[3]);
                        *(u32x4*)(XM + (size_t)row * DM + col) = w;
                        ss += (y0[0] * y0[0] + y0[1] * y0[1]) + (y0[2] * y0[2] + y0[3] * y0[3]) + (y1[0] * y1[0] + y1[1] * y1[1]) + (y1[2] * y1[2] + y1[3] * y1[3]);
                    }
                }
                if (!last) { ss += __shfl_xor(ss, 16); ss += __shfl_xor(ss, 32); if (fq == 0) atomicAdd(ssq_out + row, ss); }
            }
    }
};


__device__ __forceinline__ void thin_res_item(const bf16_t* A, const bf16_t* Bt, int K, int item, const EpiRes& E) {
    int tid_ = threadIdx.x; asm volatile("" : "+v"(tid_));
    const int tid = tid_, lane = tid & 63, wave = __builtin_amdgcn_readfirstlane(tid >> 6), fr = lane & 15, fq = lane >> 4;
    const int rg = item >> 3, cg = item & 7, n0 = cg * 128 + wave * 16;
    const int row = MP + rg * 16 + fr;
    const bf16_t* ap = A + (size_t)(MP + rg * 16) * K;
    const bf16_t* bp = Bt + (size_t)n0 * K;
    const unsigned lo = (unsigned)(fr * K + 8 * fq);
    f32x4 acc = {0.f, 0.f, 0.f, 0.f};
#pragma unroll 8
    for (int k0 = 0; k0 < K; k0 += 32) {
        const bf16x8 a = *(const bf16x8*)(ap + lo + k0), b = *(const bf16x8*)(bp + lo + k0);
        acc = __builtin_amdgcn_mfma_f32_16x16x32_bf16(b, a, acc, 0, 0, 0);
    }
    const int col = n0 + 4 * fq; const int bb = bidx_of(row);
    const float* xin = E.xin_s + (size_t)(row - MP) * DM;
    const f32x4 g = *(const f32x4*)(E.gt + (size_t)bb * MODW + col), x = *(const f32x4*)(xin + col);
    const f32x4 y = x + g * acc;
    *(f32x4*)(E.xout + (size_t)row * DM + col) = y;
    if (!E.last) {
        const f32x4 s = *(const f32x4*)(E.gain + col) * (*(const f32x4*)(E.sc + (size_t)bb * MODW + col) + 1.f), z = y * s;
        *(u32x2*)(E.XM + (size_t)row * DM + col) = (u32x2){pk2(z[0], z[1]), pk2(z[2], z[3])};
        float ss = (y[0] * y[0] + y[1] * y[1]) + (y[2] * y[2] + y[3] * y[3]);
        ss += __shfl_xor(ss, 16); ss += __shfl_xor(ss, 32);
        if (fq == 0) atomicAdd(E.ssq_out + row, ss);
    }
}

struct EpiUp {
    static constexpr bool PERM = true;
    bf16_t* ACT; float* Hfirst; float* Hlast; const float* ssq; const float* shW; const float* cw; const float* cb; const float* cstate; float* ncp; float* ncs;
    __device__ __forceinline__ void operator()(AccRef acc, const pg8::Unit& u, int wr, int wc, int fr, int fq, LAS unsigned char* xl) const {
        const int pm = u.pm, f0 = u.pn * 128 + wc * 32 + 8 * fq, toff = wr * 128 + fr * 8, row0 = pm * 256 + toff;
        const bool samp = pm >= 256;
        const int b = samp ? 32 + (pm - 256) * 8 + (toff >> 5) : (pm >> 3);
        const bool defer = !samp && wr == 0 && fr == 0, lastlane = !samp && wr == 1 && fr == 15, seqstart = samp && (fr & 3) == 0;
        float rs[8];
        { const f32x4 q0 = *(const f32x4*)(ssq + row0), q1 = *(const f32x4*)(ssq + row0 + 4);
#pragma unroll
          for (int j = 0; j < 4; ++j) { rs[j] = rsqrtf(q0[j] * (1.f / 1024.f) + EPS); rs[4 + j] = rsqrtf(q1[j] * (1.f / 1024.f) + EPS); } }
        const float* shb = shW + (size_t)b * FF2;
        LAS float* xf = (LAS float*)xl + (wc * 4 + fq) * 32;
        if (wr == 0 && fr == 15) {
#pragma unroll
            for (int n = 0; n < 2; ++n) {
                const f32x4 bu = *(const f32x4*)(shb + f0 + 4 * n), bg = *(const f32x4*)(shb + FF + f0 + 4 * n);
                *(LAS f32x4*)(xf + 0 + n * 4) = acc[1][0][2][n] * rs[6] + bu; *(LAS f32x4*)(xf + 8 + n * 4) = acc[1][1][2][n] * rs[6] + bg;
                *(LAS f32x4*)(xf + 16 + n * 4) = acc[1][0][3][n] * rs[7] + bu; *(LAS f32x4*)(xf + 24 + n * 4) = acc[1][1][3][n] * rs[7] + bg;
            }
        }
        asm volatile("s_waitcnt lgkmcnt(0)\n\ts_barrier" ::: "memory");
#pragma unroll
        for (int n = 0; n < 2; ++n) {
            const int fc = f0 + 4 * n;
            const f32x4 bu = *(const f32x4*)(shb + fc), bg = *(const f32x4*)(shb + FF + fc);
            const f32x4 w0u = *(const f32x4*)(cw + fc), w1u = *(const f32x4*)(cw + FF2 + fc), w2u = *(const f32x4*)(cw + 2 * FF2 + fc), cbu = *(const f32x4*)(cb + fc);
            const f32x4 w0g = *(const f32x4*)(cw + FF + fc), w1g = *(const f32x4*)(cw + FF2 + FF + fc), w2g = *(const f32x4*)(cw + 2 * FF2 + FF + fc), cbg = *(const f32x4*)(cb + FF + fc);
            f32x4 p2u, p1u, p2g, p1g;
            {
                const f32x4 u6 = acc[1][0][2][n] * rs[6] + bu, g6 = acc[1][1][2][n] * rs[6] + bg, u7 = acc[1][0][3][n] * rs[7] + bu, g7 = acc[1][1][3][n] * rs[7] + bg;
#pragma unroll
                for (int c = 0; c < 4; ++c) { p2u[c] = __shfl_up(u6[c], 1, 16); p1u[c] = __shfl_up(u7[c], 1, 16); p2g[c] = __shfl_up(g6[c], 1, 16); p1g[c] = __shfl_up(g7[c], 1, 16); }
            }
            if (seqstart) {
                const float* st = cstate + (size_t)(b - 32) * 2 * FF2;
                p2u = *(const f32x4*)(st + fc); p2g = *(const f32x4*)(st + FF + fc); p1u = *(const f32x4*)(st + FF2 + fc); p1g = *(const f32x4*)(st + FF2 + FF + fc);
            } else if (fr == 0 && wr == 1) {
                p2u = *(LAS f32x4*)(xf + 0 + n * 4); p2g = *(LAS f32x4*)(xf + 8 + n * 4); p1u = *(LAS f32x4*)(xf + 16 + n * 4); p1g = *(LAS f32x4*)(xf + 24 + n * 4);
            }
#pragma unroll
            for (int j = 0; j < 8; ++j) {
                const int ai = j >> 2, m = j & 3;
                const f32x4 cu = acc[ai][0][m][n] * rs[j] + bu, cg = acc[ai][1][m][n] * rs[j] + bg;
                if (defer && j < 2) {
                    float* hp = Hfirst + (size_t)(pm * 2 + j) * FF2; *(f32x4*)(hp + fc) = cu; *(f32x4*)(hp + FF + fc) = cg;
                } else {
                    const f32x4 yu = cbu + w0u * p2u + w1u * p1u + w2u * cu, yg = cbg + w0g * p2g + w1g * p1g + w2g * cg;
                    u32x2 w; w.x = pk2(silu_f(yg[0]) * yu[0], silu_f(yg[1]) * yu[1]); w.y = pk2(silu_f(yg[2]) * yu[2], silu_f(yg[3]) * yu[3]);
                    *(u32x2*)(ACT + (size_t)(row0 + j) * FF + fc) = w;
                }
                if (j >= 6) {
                    if (lastlane) { float* hp = Hlast + (size_t)(pm * 2 + (j - 6)) * FF2; *(f32x4*)(hp + fc) = cu; *(f32x4*)(hp + FF + fc) = cg;
                        if ((pm & 7) == 7) { float* cp = ncp + (size_t)((pm >> 3) * 2 + (j - 6)) * FF2; *(f32x4*)(cp + fc) = cu; *(f32x4*)(cp + FF + fc) = cg; } }
                    if (samp && (fr & 3) == 3) { float* cp = ncs + (size_t)((b - 32) * 2 + (j - 6)) * FF2; *(f32x4*)(cp + fc) = cu; *(f32x4*)(cp + FF + fc) = cg; }
                }
                p2u = p1u; p2g = p1g; p1u = cu; p1g = cg;
            }
        }
    }
};

struct EpiDiffIn {
    static constexpr bool PERM = true;
    bf16_t* Qb; bf16_t* Kb; bf16_t* Vb; float* nkp; float* nks; float* nvp; float* nvs; const float* ssq; const float* shW; const float* qg; const float* kg;
    __device__ __forceinline__ void operator()(AccRef acc, const pg8::Unit& u, int wr, int wc, int fr, int fq, LAS unsigned char*) const {
        const int pn = u.pn;
#pragma unroll
        for (int ai = 0; ai < 2; ++ai)
#pragma unroll
            for (int m = 0; m < 4; ++m) {
                const int row = u.pm * 256 + ai * 128 + wr * 64 + m * 16 + fr; const int b = bidx_of(row);
                const float rs = rsqrtf(ssq[row] * (1.f / 1024.f) + EPS);
                const float* shb = shW + (size_t)b * DIN;
                if (pn < 8) {
                    const int cg0 = pn * 256 + wc * 64 + 8 * fq;
                    f32x4 v[2][2]; float ss = 0.f;
#pragma unroll
                    for (int bj = 0; bj < 2; ++bj)
#pragma unroll
                        for (int n = 0; n < 2; ++n) { v[bj][n] = acc[ai][bj][m][n] * rs + *(const f32x4*)(shb + cg0 + 32 * bj + 4 * n);
                            ss += (v[bj][n][0] * v[bj][n][0] + v[bj][n][1] * v[bj][n][1]) + (v[bj][n][2] * v[bj][n][2] + v[bj][n][3] * v[bj][n][3]); }
                    ss += __shfl_xor(ss, 16); ss += __shfl_xor(ss, 32);
                    const float r2 = rsqrtf(ss * (1.f / 64.f) + EPS) * (pn < 4 ? QSCALE : 1.f);
                    const float* gp = (pn < 4 ? qg : kg) + 8 * fq;
#pragma unroll
                    for (int bj = 0; bj < 2; ++bj) {
                        const f32x4 o0 = v[bj][0] * r2 * *(const f32x4*)(gp + 32 * bj), o1 = v[bj][1] * r2 * *(const f32x4*)(gp + 32 * bj + 4);
                        u32x4 w; w.x = pk2(o0[0], o0[1]); w.y = pk2(o0[2], o0[3]); w.z = pk2(o1[0], o1[1]); w.w = pk2(o1[2], o1[3]);
                        const int col = cg0 + 32 * bj;
                        if (pn < 4) *(u32x4*)(Qb + (size_t)row * DM + col) = w;
                        else { const int kc = col - 1024; *(u32x4*)(Kb + (size_t)row * DM + kc) = w;
                            float* op = (row < MP ? nkp + (size_t)row * DM : nks + (size_t)(row - MP) * DM) + kc; __builtin_nontemporal_store(o0, (f32x4*)op); __builtin_nontemporal_store(o1, (f32x4*)(op + 4)); }
                    }
                } else {
#pragma unroll
                    for (int bj = 0; bj < 2; ++bj) {
                        const int col = pn * 256 + bj * 128 + wc * 32 + 8 * fq, vc = col - 2048;
                        const f32x4 o0 = acc[ai][bj][m][0] * rs + *(const f32x4*)(shb + col), o1 = acc[ai][bj][m][1] * rs + *(const f32x4*)(shb + col + 4);
                        u32x4 w; w.x = pk2(o0[0], o0[1]); w.y = pk2(o0[2], o0[3]); w.z = pk2(o1[0], o1[1]); w.w = pk2(o1[2], o1[3]);
                        *(u32x4*)(Vb + (size_t)row * DM + vc) = w;
                        float* op = (row < MP ? nvp + (size_t)row * DM : nvs + (size_t)(row - MP) * DM) + vc; __builtin_nontemporal_store(o0, (f32x4*)op); __builtin_nontemporal_store(o1, (f32x4*)(op + 4));
                    }
                }
            }
    }
};

__device__ __forceinline__ int slot_col(int mapid, int s) {
    if (mapid == 1) { const int pn = s >> 8, bj = (s >> 7) & 1, r = s & 127; return FF * bj + 128 * pn + r; }
    if (mapid == 2) { if (s >= 2048) return s; const int pn = s >> 8, bj = (s >> 7) & 1, wc = (s >> 5) & 3, l5 = s & 31; return 256 * pn + 64 * wc + 32 * bj + l5; }
    return s;
}
__device__ __forceinline__ void transpose_item(const float* W, int ldw, int nvalid, int K, int nslots, bf16_t* WT, int mapid, LAS float* scr, int item, int lane) {
    const int nblk = nslots / 32, kb = item / nblk, nb = item % nblk, k0 = 64 * kb, s0 = 32 * nb, c0 = slot_col(mapid, s0);
    const int cc = c0 + (lane & 31); const bool ok = cc < nvalid;
#pragma unroll 8
    for (int i = 0; i < 32; ++i) { const int kk = 2 * i + (lane >> 5); scr[kk * 33 + (lane & 31)] = ok ? W[(size_t)(k0 + kk) * ldw + cc] : 0.f; }
    asm volatile("s_waitcnt lgkmcnt(0)" ::: "memory");
    const int c = lane & 7;
#pragma unroll
    for (int j = 0; j < 4; ++j) { const int n = (lane >> 3) + 8 * j; const LAS float* s = scr + (8 * c) * 33 + n;
        u32x4 o; o.x = pk2(s[0 * 33], s[1 * 33]); o.y = pk2(s[2 * 33], s[3 * 33]); o.z = pk2(s[4 * 33], s[5 * 33]); o.w = pk2(s[6 * 33], s[7 * 33]);
        *(u32x4*)(WT + (size_t)(s0 + n) * K + k0 + 8 * c) = o; }
    asm volatile("s_waitcnt lgkmcnt(0)" ::: "memory");
}

template <class ActF>
__device__ __forceinline__ void sg48_item(const float* W, int ldw, int nvalid, const float* bias, float* out, int ldo, int n0, ActF actf, LAS unsigned char* lds) {
    int tid_ = threadIdx.x; asm volatile("" : "+v"(tid_));
    const int tid = tid_, wave = __builtin_amdgcn_readfirstlane(tid >> 6), lane = tid & 63, r = lane & 31, hh = lane >> 5;
    LAS unsigned char* A = lds;
    LAS float* P = (LAS float*)(lds + 99328);
#pragma unroll 4
    for (int it = 0; it < 24; ++it) {
        const int i = tid + 512 * it, b = i >> 8, k4 = (i & 255) * 4;
        const f32x4 v = actf(b, k4);
        *(LAS u32x2*)(A + b * 2064 + k4 * 2) = (u32x2){pk2(v[0], v[1]), pk2(v[2], v[3])};
    }
    for (int i = tid; i < NB * 64; i += 512) P[i] = 0.f;
    __syncthreads();
    f32x16 acc[2][2];
#pragma unroll
    for (int bb = 0; bb < 2; ++bb)
#pragma unroll
        for (int nb = 0; nb < 2; ++nb)
#pragma unroll
            for (int i = 0; i < 16; ++i) acc[bb][nb][i] = 0.f;
    const int kbase = wave * 128;
    int ncol[2]; bool okc[2];
#pragma unroll
    for (int nb = 0; nb < 2; ++nb) { ncol[nb] = n0 + 32 * nb + r; okc[nb] = ncol[nb] < nvalid; if (!okc[nb]) ncol[nb] = 0; }
    const int brow1 = (32 + r < NB) ? 32 + r : NB - 1;
    float wv[2][2][8];
#pragma unroll
    for (int nb = 0; nb < 2; ++nb)
#pragma unroll
        for (int j = 0; j < 8; ++j) wv[0][nb][j] = W[(size_t)(kbase + 8 * hh + j) * ldw + ncol[nb]];
#pragma unroll
    for (int ks = 0; ks < 8; ++ks) {
        if (ks + 1 < 8) {
#pragma unroll
            for (int nb = 0; nb < 2; ++nb)
#pragma unroll
                for (int j = 0; j < 8; ++j) wv[(ks + 1) & 1][nb][j] = W[(size_t)(kbase + 16 * (ks + 1) + 8 * hh + j) * ldw + ncol[nb]];
        }
        const bf16x8 a0 = *(const LAS bf16x8*)(A + r * 2064 + (kbase + 16 * ks + 8 * hh) * 2), a1 = *(const LAS bf16x8*)(A + brow1 * 2064 + (kbase + 16 * ks + 8 * hh) * 2);
#pragma unroll
        for (int nb = 0; nb < 2; ++nb) {
            u32x4 pw;
#pragma unroll
            for (int j = 0; j < 4; ++j) pw[j] = okc[nb] ? pk2(wv[ks & 1][nb][2 * j], wv[ks & 1][nb][2 * j + 1]) : 0u;
            const bf16x8 bw = __builtin_bit_cast(bf16x8, pw);
            acc[0][nb] = MFMA32(a0, bw, acc[0][nb]); acc[1][nb] = MFMA32(a1, bw, acc[1][nb]);
        }
    }
    for (int w8 = 0; w8 < 8; ++w8) {
        if (wave == w8) {
#pragma unroll
            for (int nb = 0; nb < 2; ++nb) {
#pragma unroll
                for (int i = 0; i < 16; ++i) P[crow(i, hh) * 64 + 32 * nb + r] += acc[0][nb][i];
#pragma unroll
                for (int i = 0; i < 8; ++i) P[(32 + crow(i, hh)) * 64 + 32 * nb + r] += acc[1][nb][i];
            }
        }
        __syncthreads();
    }
    for (int i = tid; i < NB * 64; i += 512) { const int b = i >> 6, nn = n0 + (i & 63); if (nn < nvalid) out[(size_t)b * ldo + nn] = P[i] + (bias ? bias[nn] : 0.f); }
    __syncthreads();
}

constexpr int GL_QE = 0, GL_KE = 17408, GL_KDT = 34816, GL_V = 53248, GL_ATT = 90112, GL_ALOW = 99328, GL_BQ = 103424, GL_DEC = 107520, GL_SSQ = 108032, GL_V1 = 110080, GL_ALOW1 = 146944;
__device__ __forceinline__ bf16x8 pack8(const f32x16& x, int s) {
    u32x4 p; p.x = pk2(x[8 * s], x[8 * s + 1]); p.y = pk2(x[8 * s + 2], x[8 * s + 3]); p.z = pk2(x[8 * s + 4], x[8 * s + 5]); p.w = pk2(x[8 * s + 6], x[8 * s + 7]);
    return __builtin_bit_cast(bf16x8, p);
}
__device__ __forceinline__ s16x4 tr_read(LAS unsigned char* p) { return __builtin_bit_cast(s16x4, __builtin_amdgcn_ds_read_tr16_b64_v4i16((LAS v4i16_t*)p)); }
__device__ __forceinline__ bf16x8 cat8(s16x4 lo, s16x4 hi) { return (bf16x8){lo[0], lo[1], lo[2], lo[3], hi[0], hi[1], hi[2], hi[3]}; }

#define LBAR() asm volatile("s_waitcnt lgkmcnt(0)\n\ts_barrier" ::: "memory")
template <int C>
__device__ __forceinline__ void gla_unit(const bf16_t* QKVR, const float* alow, const float* w_alpha, const float* b_alpha, const float* gnorm, bf16_t* O,
                                         int rowbase, int T, int h, const float* S0, float* Sout, LAS unsigned char* lds) {
    constexpr int NTB = C / 32, NKS = C / 16, NE = C / 8;
    int tid_ = threadIdx.x; asm volatile("" : "+v"(tid_));
    const int tid = tid_, lane = tid & 63, w = __builtin_amdgcn_readfirstlane(tid >> 6), r = lane & 31, hh = lane >> 5;
    const int e_lane = 32 * w + r;
    f32x16 S[4];
#pragma unroll
    for (int db = 0; db < 4; ++db)
#pragma unroll
        for (int i = 0; i < 16; ++i) S[db][i] = S0 ? S0[(size_t)(32 * db + crow(i, hh)) * 256 + e_lane] : 0.f;
    const int d0 = 2 * lane, te = w;
    const unsigned lo_v = (unsigned)((tid >> 5) * 3072 + (tid & 31) * 8), lo_q = (unsigned)d0, lo_r = (unsigned)(r * 3072 + 4 * hh), lo_o = (unsigned)(r * 1024 + 4 * hh), lo_a = (unsigned)((tid < C * 4 ? tid : C * 4 - 1) * 4);
    const bool p1act = (te * 8 < C);
    const float bal0 = b_alpha[h * 128 + d0], bal1 = b_alpha[h * 128 + d0 + 1];
    const int ltb = w >> 2, ldb = w & 3;
    const bool lact = (ltb < NTB);
    bf16x8 wbh;
    {
        float wv[8];
#pragma unroll
        for (int j = 0; j < 8; ++j) wv[j] = w_alpha[(8 * hh + j) * 512 + h * 128 + 32 * ldb + r];
        u32x4 ph;
#pragma unroll
        for (int j = 0; j < 4; ++j) ph[j] = pk2(wv[2 * j], wv[2 * j + 1]);
        wbh = __builtin_bit_cast(bf16x8, ph);
    }
    LAS float* BQ = (LAS float*)(lds + GL_BQ); LAS float* DEC = (LAS float*)(lds + GL_DEC); LAS float* SSQ = (LAS float*)(lds + GL_SSQ);
    LAS unsigned char* LG = lds + GL_QE;
    const int nch = T / C;
    if (tid < C * 4) *(LAS f32x4*)(lds + GL_ALOW + tid * 16) = *(const f32x4*)(alow + (size_t)rowbase * 16 + tid * 4);
    for (int i = tid; i < C * 32; i += 512) { const int s = i >> 5, ch = i & 31; *(LAS u32x4*)(lds + GL_V + s * 576 + ch * 16) = *(const u32x4*)(QKVR + (size_t)(rowbase + s) * 3072 + 1024 + h * 256 + ch * 8); }
    unsigned qreg[8], kreg[8];
    if (p1act) {
#pragma unroll
        for (int i = 0; i < 8; ++i) { const bf16_t* qp = QKVR + (size_t)(rowbase + 8 * te + i) * 3072 + h * 128; qreg[i] = *(const unsigned*)(qp + lo_q); kreg[i] = *(const unsigned*)(qp + 512 + lo_q); }
    }
    for (int ci = 0; ci < nch; ++ci) {
        const int row0 = rowbase + ci * C;
        const bool has_next = ci + 1 < nch;
        LAS unsigned char* Vc = lds + ((ci & 1) ? GL_V1 : GL_V); LAS unsigned char* Ac = lds + ((ci & 1) ? GL_ALOW1 : GL_ALOW);
        LBAR();
        u32x4 vn[C / 16]; f32x4 an;
        if (has_next) {
            const int rn = row0 + C;
#pragma unroll
            for (int k = 0; k < C / 16; ++k) { const bf16_t* vp = QKVR + (size_t)(rn + 16 * k) * 3072 + 1024 + h * 256; vn[k] = *(const u32x4*)(vp + lo_v); }
            { const float* apn = alow + (size_t)rn * 16; an = *(const f32x4*)(apn + lo_a); }
        }
        if (lact) {
            const LAS f32x4* ap = (const LAS f32x4*)(Ac + (32 * ltb + r) * 64 + hh * 32);
            const f32x4 a0 = ap[0], a1 = ap[1];
            u32x4 ph, pl;
            ph[0] = pk2(a0[0], a0[1]); ph[1] = pk2(a0[2], a0[3]); ph[2] = pk2(a1[0], a1[1]); ph[3] = pk2(a1[2], a1[3]);
            pl[0] = pk2(a0[0] - bflo(ph[0]), a0[1] - bfhi(ph[0])); pl[1] = pk2(a0[2] - bflo(ph[1]), a0[3] - bfhi(ph[1]));
            pl[2] = pk2(a1[0] - bflo(ph[2]), a1[1] - bfhi(ph[2])); pl[3] = pk2(a1[2] - bflo(ph[3]), a1[3] - bfhi(ph[3]));
            const bf16x8 ah = __builtin_bit_cast(bf16x8, ph), al = __builtin_bit_cast(bf16x8, pl);
            f32x16 lgv;
#pragma unroll
            for (int i = 0; i < 16; ++i) lgv[i] = 0.f;
            lgv = MFMA32(ah, wbh, lgv); lgv = MFMA32(al, wbh, lgv);
#pragma unroll
            for (int i = 0; i < 16; ++i) *(LAS float*)(LG + (32 * ltb + crow(i, hh)) * 528 + (32 * ldb + r) * 4) = lgv[i];
        }
        LBAR();
        float bl0[8], bl1[8]; float run0 = 0.f, run1 = 0.f;
        if (p1act) {
#pragma unroll
            for (int i = 0; i < 8; ++i) {
                const f32x2_t lv = *(const LAS f32x2_t*)(LG + (8 * te + i) * 528 + d0 * 4);
                const float l0 = lv[0] + bal0, l1 = lv[1] + bal1;
                run0 += (fminf(l0, 0.f) - __logf(1.f + __expf(-fabsf(l0)))) * (1.f / 16.f); bl0[i] = run0;
                run1 += (fminf(l1, 0.f) - __logf(1.f + __expf(-fabsf(l1)))) * (1.f / 16.f); bl1[i] = run1;
            }
            *(LAS f32x2_t*)(BQ + te * 128 + d0) = (f32x2_t){run0, run1};
        }
        if (has_next) {
            LAS unsigned char* Vn = lds + (((ci + 1) & 1) ? GL_V1 : GL_V); LAS unsigned char* An = lds + (((ci + 1) & 1) ? GL_ALOW1 : GL_ALOW);
#pragma unroll
            for (int k = 0; k < C / 16; ++k) { const int i = tid + 512 * k, s = i >> 5, ch = i & 31; *(LAS u32x4*)(Vn + s * 576 + ch * 16) = vn[k]; }
            if (tid < C * 4) *(LAS f32x4*)(An + tid * 16) = an;
        }
        LBAR();
        if (p1act) {
            float off0 = 0.f, off1 = 0.f, tot0 = 0.f, tot1 = 0.f;
#pragma unroll
            for (int q2 = 0; q2 < NE; ++q2) { const f32x2_t v = *(const LAS f32x2_t*)(BQ + q2 * 128 + d0); if (q2 < te) { off0 += v[0]; off1 += v[1]; } tot0 += v[0]; tot1 += v[1]; }
            float kd0[8], kd1[8];
#pragma unroll
            for (int i = 0; i < 8; ++i) {
                const int t = 8 * te + i; const float b0 = bl0[i] + off0, b1 = bl1[i] + off1;
                const float q0 = bflo(qreg[i]), q1 = bfhi(qreg[i]), k0 = bflo(kreg[i]), k1 = bfhi(kreg[i]);
                *(LAS unsigned*)(lds + GL_QE + t * 272 + d0 * 2) = pk2(q0 * GLA_QSC * __expf(b0), q1 * GLA_QSC * __expf(b1));
                *(LAS unsigned*)(lds + GL_KE + t * 272 + d0 * 2) = pk2(k0 * __expf(-b0), k1 * __expf(-b1));
                kd0[i] = k0 * __expf(tot0 - b0); kd1[i] = k1 * __expf(tot1 - b1);
            }
            *(LAS u32x4*)(lds + GL_KDT + d0 * 144 + te * 16) = (u32x4){pk2(kd0[0], kd0[1]), pk2(kd0[2], kd0[3]), pk2(kd0[4], kd0[5]), pk2(kd0[6], kd0[7])};
            *(LAS u32x4*)(lds + GL_KDT + (d0 + 1) * 144 + te * 16) = (u32x4){pk2(kd1[0], kd1[1]), pk2(kd1[2], kd1[3]), pk2(kd1[4], kd1[5]), pk2(kd1[6], kd1[7])};
            if (te == 0) *(LAS f32x2_t*)(DEC + d0) = (f32x2_t){__expf(tot0), __expf(tot1)};
        }
        LBAR();
        if (w < (NTB == 2 ? 3 : 1)) {
            const int sb = (w == 2) ? 1 : 0, tb = (w == 0) ? 0 : 1;
            f32x16 a;
#pragma unroll
            for (int i = 0; i < 16; ++i) a[i] = 0.f;
#pragma unroll
            for (int ks = 0; ks < 8; ++ks) {
                const bf16x8 A = *(const LAS bf16x8*)(lds + GL_KE + (32 * sb + r) * 272 + (16 * ks + 8 * hh) * 2);
                const bf16x8 B = *(const LAS bf16x8*)(lds + GL_QE + (32 * tb + r) * 272 + (16 * ks + 8 * hh) * 2);
                a = MFMA32(A, B, a);
            }
            const int t = 32 * tb + r;
#pragma unroll
            for (int g = 0; g < 4; ++g) {
                const int sbase = 32 * sb + 8 * g + 4 * hh;
                const float v0 = (sbase + 0 <= t) ? a[4 * g + 0] : 0.f, v1 = (sbase + 1 <= t) ? a[4 * g + 1] : 0.f, v2 = (sbase + 2 <= t) ? a[4 * g + 2] : 0.f, v3 = (sbase + 3 <= t) ? a[4 * g + 3] : 0.f;
                *(LAS u32x2*)(lds + GL_ATT + t * 144 + sbase * 2) = (u32x2){pk2(v0, v1), pk2(v2, v3)};
            }
        }
        f32x16 o[NTB];
#pragma unroll
        for (int tb = 0; tb < NTB; ++tb)
#pragma unroll
            for (int i = 0; i < 16; ++i) o[tb][i] = 0.f;
#pragma unroll
        for (int db = 0; db < 4; ++db)
#pragma unroll
            for (int s2 = 0; s2 < 2; ++s2) {
                const bf16x8 A = pack8(S[db], s2);
#pragma unroll
                for (int tb = 0; tb < NTB; ++tb) {
                    LAS unsigned char* qb = lds + GL_QE + (32 * tb + r) * 272 + (32 * db + 16 * s2 + 4 * hh) * 2;
                    const s16x4 lo = *(const LAS s16x4*)qb, hi = *(const LAS s16x4*)(qb + 16);
                    o[tb] = MFMA32(A, cat8(lo, hi), o[tb]);
                }
                __builtin_amdgcn_sched_barrier(0);
            }
        LBAR();
        u32x2 rg[NTB][4];
#pragma unroll
        for (int tb = 0; tb < NTB; ++tb)
#pragma unroll
            for (int g = 0; g < 4; ++g) { const bf16_t* rp = QKVR + (size_t)(row0 + 32 * tb) * 3072 + 2048 + h * 256 + 32 * w + 8 * g; rg[tb][g] = *(const u32x2*)(rp + lo_r); }
        bf16x8 vf[NKS];
#pragma unroll
        for (int ks = 0; ks < NKS; ++ks) {
            LAS unsigned char* vb = Vc + (16 * ks + 8 * hh + ((lane & 15) >> 2)) * 576 + (32 * w + 16 * ((lane >> 4) & 1) + 4 * (lane & 3)) * 2;
            vf[ks] = cat8(tr_read(vb), tr_read(vb + 4 * 576));
        }
#pragma unroll
        for (int tb = 0; tb < NTB; ++tb)
#pragma unroll
            for (int ks = 0; ks < NKS; ++ks) {
                if (tb == 0 && ks >= 2) continue;
                const bf16x8 B = *(const LAS bf16x8*)(lds + GL_ATT + (32 * tb + r) * 144 + (16 * ks + 8 * hh) * 2);
                o[tb] = MFMA32(vf[ks], B, o[tb]);
            }
#pragma unroll
        for (int db = 0; db < 4; ++db) {
#pragma unroll
            for (int g = 0; g < 4; ++g) { const f32x4 dc = *(const LAS f32x4*)(DEC + 32 * db + 8 * g + 4 * hh);
                S[db][4 * g] *= dc[0]; S[db][4 * g + 1] *= dc[1]; S[db][4 * g + 2] *= dc[2]; S[db][4 * g + 3] *= dc[3]; }
#pragma unroll
            for (int ks = 0; ks < NKS; ++ks) {
                const bf16x8 A = *(const LAS bf16x8*)(lds + GL_KDT + (32 * db + r) * 144 + (16 * ks + 8 * hh) * 2);
                S[db] = MFMA32(A, vf[ks], S[db]);
            }
            __builtin_amdgcn_sched_barrier(0);
        }
#pragma unroll
        for (int tb = 0; tb < NTB; ++tb) {
            float q = 0.f;
#pragma unroll
            for (int i = 0; i < 16; ++i) q += o[tb][i] * o[tb][i];
            q += __shfl_xor(q, 32);
            if (hh == 0) SSQ[w * 64 + 32 * tb + r] = q;
        }
        LBAR();
        if (has_next) {
            const int rn = row0 + C;
            int l2_ = threadIdx.x; asm volatile("" : "+v"(l2_)); const unsigned lo_q2 = 2u * (unsigned)(l2_ & 63);
            if (p1act) {
#pragma unroll
                for (int i = 0; i < 8; ++i) { const bf16_t* qp = QKVR + (size_t)(rn + 8 * te + i) * 3072 + h * 128; qreg[i] = *(const unsigned*)(qp + lo_q2); kreg[i] = *(const unsigned*)(qp + 512 + lo_q2); }
            }
        }
#pragma unroll
        for (int tb = 0; tb < NTB; ++tb) {
            const int t = 32 * tb + r;
            float tot = 0.f;
#pragma unroll
            for (int w2 = 0; w2 < 8; ++w2) tot += SSQ[w2 * 64 + t];
            const float rs = rsqrtf(tot * (1.f / 256.f) + EPS);
#pragma unroll
            for (int g = 0; g < 4; ++g) {
                const int e0 = 32 * w + 8 * g + 4 * hh;
                const f32x4 gnv = *(const f32x4*)(gnorm + 32 * w + 8 * g + (unsigned)(4 * hh));
                const u32x2 rr = rg[tb][g];
                const float y0 = o[tb][4 * g] * rs * gnv[0] * silu_f(bflo(rr.x)), y1 = o[tb][4 * g + 1] * rs * gnv[1] * silu_f(bfhi(rr.x));
                const float y2 = o[tb][4 * g + 2] * rs * gnv[2] * silu_f(bflo(rr.y)), y3 = o[tb][4 * g + 3] * rs * gnv[3] * silu_f(bfhi(rr.y));
                { bf16_t* op = O + (size_t)(row0 + 32 * tb) * DM + h * 256 + 32 * w + 8 * g; *(u32x2*)(op + lo_o) = (u32x2){pk2(y0, y1), pk2(y2, y3)}; }
            }
        }
    }
    {
        int t2 = threadIdx.x; asm volatile("" : "+v"(t2));
        const unsigned lo_s = (unsigned)(4 * ((t2 & 63) >> 5) * 256 + 32 * (t2 >> 6) + (t2 & 31));
#pragma unroll
        for (int db = 0; db < 4; ++db)
#pragma unroll
            for (int i = 0; i < 16; ++i) { float* sp = Sout + (size_t)(32 * db + (i & 3) + 8 * (i >> 2)) * 256; sp[lo_s] = S[db][i]; }
    }
    __syncthreads();
}

constexpr int AT_X = 36864;
struct AttnSrc { const bf16_t* Qb; const bf16_t* Kb; const bf16_t* Vb; const bf16_t* KC; const bf16_t* VC; bf16_t* O; const float* dnorm; };

__device__ __forceinline__ void attn_unit(const AttnSrc& A, int grp, int b, int h, int qb, float lam, LAS unsigned char* lds) {
    int tid_ = threadIdx.x; asm volatile("" : "+v"(tid_));
    const int tid = tid_, lane = tid & 63, w = __builtin_amdgcn_readfirstlane(tid >> 6), r = lane & 31, hh = lane >> 5;
    const int c = w & 1, rb = w >> 1;
    const int rowbase = grp == 0 ? b * 2048 : MP + b * 32;
    const int p0 = grp == 0 ? 128 * qb : 0;
    const int NT = grp == 0 ? 2 * qb + 2 : 33;
    const bool active = grp == 0 ? true : (rb == 0);
    const int my_last = grp == 0 ? 2 * qb + (rb >> 1) : 32;
    bf16x8 qf[4];
    {
        const bf16_t* Qw = A.Qb + (size_t)(rowbase + p0 + (active ? 32 * rb : 0) + r) * DM + h * 128 + c * 64 + 8 * hh;
#pragma unroll
        for (int ks = 0; ks < 4; ++ks) qf[ks] = *(const bf16x8*)(Qw + 16 * ks);
    }
    f32x16 Oa[4];
#pragma unroll
    for (int d = 0; d < 4; ++d)
#pragma unroll
        for (int i = 0; i < 16; ++i) Oa[d][i] = 0.f;
    float m_run = 0.f, lsum = 0.f;
    u32x4 kreg[2], vreg[2];
#define LOAD_TILE(t_) do { _Pragma("unroll") for (int i_ = 0; i_ < 2; ++i_) { \
            const int id_ = tid + 512 * i_, row_ = id_ >> 4, ch_ = id_ & 15, key_ = 64 * (t_) + row_; \
            const bf16_t* kp_; const bf16_t* vp_; bool ok_ = true; \
            if (grp == 0) { const size_t o_ = (size_t)(rowbase + key_) * DM + h * 128 + ch_ * 8; kp_ = A.Kb + o_; vp_ = A.Vb + o_; } \
            else if (key_ < 2048) { const size_t o_ = (size_t)(b * 2048 + key_) * DM + h * 128 + ch_ * 8; kp_ = A.KC + o_; vp_ = A.VC + o_; } \
            else { ok_ = key_ < 2080; const size_t o_ = (size_t)(rowbase + (ok_ ? key_ - 2048 : 0)) * DM + h * 128 + ch_ * 8; kp_ = A.Kb + o_; vp_ = A.Vb + o_; } \
            kreg[i_] = *(const u32x4*)kp_; vreg[i_] = *(const u32x4*)vp_; \
            if (!ok_) { kreg[i_] = (u32x4){0u, 0u, 0u, 0u}; vreg[i_] = (u32x4){0u, 0u, 0u, 0u}; } } } while (0)
    LOAD_TILE(0);
    const bool grpB = (w >= 4);
    bf16x8 pw[4];
#define QK_SOFTMAX(t_) do { \
        LAS unsigned char* Kt = lds + ((t_) % 3) * 32768; \
        f32x16 s0, s1; \
        _Pragma("unroll") for (int i = 0; i < 16; ++i) { s0[i] = 0.f; s1[i] = 0.f; } \
        _Pragma("unroll") for (int ks = 0; ks < 4; ++ks) { \
            const int chx = ((8 * c + 2 * ks + hh) ^ (r & 15)) * 16; \
            const bf16x8 a0 = *(const LAS bf16x8*)(Kt + r * 256 + chx), a1 = *(const LAS bf16x8*)(Kt + (32 + r) * 256 + chx); \
            s0 = MFMA32(a0, qf[ks], s0); s1 = MFMA32(a1, qf[ks], s1); } \
        if (grp == 1 && (t_) == 32) { _Pragma("unroll") for (int i = 0; i < 16; ++i) s1[i] = -1e30f; } \
          \
          \
        float ps = 0.f; \
        _Pragma("unroll") for (int i = 0; i < 16; ++i) { s0[i] = __builtin_amdgcn_exp2f(s0[i]); s1[i] = __builtin_amdgcn_exp2f(s1[i]); ps += s0[i] + s1[i]; } \
        lsum += ps; \
        pw[0] = pack8(s0, 0); pw[1] = pack8(s0, 1); pw[2] = pack8(s1, 0); pw[3] = pack8(s1, 1); \
    } while (0)
#define PV_STEP(t_) do { \
        LAS unsigned char* Vt = lds + ((t_) % 3) * 32768 + 16384; \
        const int i4 = (lane >> 2) & 3, p = lane & 3, g16 = (lane >> 4) & 1; \
        _Pragma("unroll") for (int bs = 0; bs < 4; ++bs) { \
            const int k0 = 16 * bs + 4 * hh; \
            _Pragma("unroll") for (int d = 0; d < 4; ++d) { \
                const int chv = ((4 * d + 2 * g16 + (p >> 1)) ^ (4 * i4)) * 16 + 8 * (p & 1); \
                const s16x4 lo = tr_read(Vt + (k0 + i4) * 256 + chv), hi = tr_read(Vt + (k0 + 8 + i4) * 256 + chv); \
                Oa[d] = MFMA32(cat8(lo, hi), pw[bs], Oa[d]); } } \
    } while (0)
#define SAMPLE_STEP(t_, S2_) do { \
        LAS unsigned char* Kt = lds + ((t_) % 3) * 32768; LAS unsigned char* Vt = Kt + 16384; \
        f32x16 sv; \
        _Pragma("unroll") for (int i = 0; i < 16; ++i) sv[i] = 0.f; \
        _Pragma("unroll") for (int ks = 0; ks < 4; ++ks) { \
            const int chx = ((8 * c + 2 * ks + hh) ^ (r & 15)) * 16; \
            const bf16x8 a0 = *(const LAS bf16x8*)(Kt + (32 * sblk + r) * 256 + chx); \
            sv = MFMA32(a0, qf[ks], sv); } \
        float ps = 0.f; \
        _Pragma("unroll") for (int j = 0; j < 8; ++j) { sv[8 * (S2_) + j] = __builtin_amdgcn_exp2f(sv[8 * (S2_) + j]); ps += sv[8 * (S2_) + j]; } \
        lsum += ps; \
        const bf16x8 pwv = pack8(sv, (S2_)); \
        const int i4 = (lane >> 2) & 3, p = lane & 3, g16 = (lane >> 4) & 1; \
        const int k0 = 16 * (2 * sblk + (S2_)) + 4 * hh; \
        _Pragma("unroll") for (int d = 0; d < 4; ++d) { \
            const int chv = ((4 * d + 2 * g16 + (p >> 1)) ^ (4 * i4)) * 16 + 8 * (p & 1); \
            const s16x4 lo = tr_read(Vt + (k0 + i4) * 256 + chv), hi = tr_read(Vt + (k0 + 8 + i4) * 256 + chv); \
            Oa[d] = MFMA32(cat8(lo, hi), pwv, Oa[d]); } \
    } while (0)
    if (grp == 1) {
        const int sblk = rb >> 1;
        for (int t = 0; t < NT; ++t) {
            LAS unsigned char* Kt = lds + (t % 3) * 32768; LAS unsigned char* Vt = Kt + 16384;
#pragma unroll
            for (int i = 0; i < 2; ++i) {
                const int id = tid + 512 * i, row = id >> 4, ch = id & 15;
                *(LAS u32x4*)(Kt + row * 256 + ((ch ^ (row & 15)) * 16)) = kreg[i];
                *(LAS u32x4*)(Vt + row * 256 + ((ch ^ (4 * (row & 3))) * 16)) = vreg[i];
            }
            __syncthreads();
            if (t + 1 < NT) LOAD_TILE(t + 1);
            if (!(t == 32 && sblk == 1)) { if (rb & 1) SAMPLE_STEP(t, 1); else SAMPLE_STEP(t, 0); }
        }
        __syncthreads();
        {
            const float lw = lsum + __shfl_xor(lsum, 32);
            LAS float* Pw = (LAS float*)(lds + w * 16384);
#pragma unroll
            for (int d = 0; d < 4; ++d)
#pragma unroll
                for (int i = 0; i < 16; ++i) Pw[(d * 16 + i) * 64 + lane] = Oa[d][i];
            ((LAS float*)(lds + 131072 + w * 256))[lane] = lw;
            __syncthreads();
            if (rb == 0) {
                float lt = lw;
#pragma unroll
                for (int rb2 = 1; rb2 < 4; ++rb2) {
                    const LAS float* P2 = (const LAS float*)(lds + (2 * rb2 + c) * 16384);
#pragma unroll
                    for (int d = 0; d < 4; ++d)
#pragma unroll
                        for (int i = 0; i < 16; ++i) Oa[d][i] += P2[(d * 16 + i) * 64 + lane];
                    lt += ((const LAS float*)(lds + 131072 + (2 * rb2 + c) * 256))[lane];
                }
                lsum = 0.5f * lt;
            }
        }
    } else {
    for (int t = 0; t <= NT; ++t) {
        if (t < NT) {
            LAS unsigned char* Kt = lds + (t % 3) * 32768; LAS unsigned char* Vt = Kt + 16384;
#pragma unroll
            for (int i = 0; i < 2; ++i) {
                const int id = tid + 512 * i, row = id >> 4, ch = id & 15;
                *(LAS u32x4*)(Kt + row * 256 + ((ch ^ (row & 15)) * 16)) = kreg[i];
                *(LAS u32x4*)(Vt + row * 256 + ((ch ^ (4 * (row & 3))) * 16)) = vreg[i];
            }
        }
        __syncthreads();
        if (t + 1 < NT) LOAD_TILE(t + 1);
        const bool doqk = active && t < NT && t <= my_last;
        if (active && grpB && t >= 1 && t - 1 <= my_last) PV_STEP(t - 1);
        if (doqk) QK_SOFTMAX(t);
        if (doqk && !grpB) PV_STEP(t);
    }
    }
    __syncthreads();
    lsum += __shfl_xor(lsum, 32);
    const float inv = active ? 1.f / lsum : 0.f;
    LAS float* X = (LAS float*)(lds + AT_X + rb * 16384);
    if (active && c == 1) {
#pragma unroll
        for (int d = 0; d < 4; ++d)
#pragma unroll
            for (int i = 0; i < 16; ++i) X[(d * 16 + i) * 64 + lane] = Oa[d][i] * inv;
    }
    __syncthreads();
    if (active && c == 0) {
        float q = 0.f;
#pragma unroll
        for (int d = 0; d < 4; ++d)
#pragma unroll
            for (int i = 0; i < 16; ++i) { const float v = Oa[d][i] * inv - lam * X[(d * 16 + i) * 64 + lane]; Oa[d][i] = v; q += v * v; }
        q += __shfl_xor(q, 32);
        const float rs = rsqrtf(q * (1.f / 128.f) + EPS) * (1.f - LAM_INIT1);
        LAS unsigned char* OT = lds + rb * 8704;
#pragma unroll
        for (int d = 0; d < 4; ++d)
#pragma unroll
            for (int g = 0; g < 4; ++g) {
                const int dv = 32 * d + 8 * g + 4 * hh; const f32x4 gnv = *(const f32x4*)(A.dnorm + dv);
                *(LAS u32x2*)(OT + r * 272 + dv * 2) = (u32x2){pk2(Oa[d][4 * g] * rs * gnv[0], Oa[d][4 * g + 1] * rs * gnv[1]), pk2(Oa[d][4 * g + 2] * rs * gnv[2], Oa[d][4 * g + 3] * rs * gnv[3])};
            }
        asm volatile("s_waitcnt lgkmcnt(0)" ::: "memory");
#pragma unroll
        for (int k = 0; k < 8; ++k) {
            const int id = lane + 64 * k, row = id >> 4, ch = id & 15;
            const u32x4 v = *(const LAS u32x4*)(OT + row * 272 + ch * 16);
            *(u32x4*)(A.O + (size_t)(rowbase + p0 + 32 * rb + row) * DM + h * 128 + ch * 8) = v;
        }
    }
    __syncthreads();
}

#ifndef REP_P0
#define REP_P0 1
#endif
#ifndef REP_P2
#define REP_P2 1
#endif
#ifndef REP_G
#define REP_G 1
#endif
#ifndef REP_U
#define REP_U 1
#endif
#ifndef REP_A
#define REP_A 1
#endif
struct Args { const float* in[27]; float* out; unsigned char* ws; };
enum { I_XP = 0, I_XS, I_SGLA, I_CK, I_CV, I_SCONV, I_CP, I_CS, I_NMIX, I_NFFN, I_WADA, I_BADA, I_GWIN, I_GWAL, I_GBAL, I_GNORM, I_GWOUT, I_DWIN, I_DQN, I_DKN, I_DLAM, I_DNORM, I_DWOUT, I_FWIN, I_FCW, I_FCB, I_FWOUT };

#define XB_TMO      128
#define XB_XCNT(j)  (256  + 64 * (j))
#define XB_XSUB(j)  (1280 + 64 * (j))
#define XB_XGEN(j)  (2304 + 64 * (j))
#define XB_TOP      3328
#define XB_TOPGEN   3392
#define XCD_BAR_WORDS 3456
#define XB_SPIN_CAP (1u << 18)

__device__ __forceinline__ unsigned xb_ld(unsigned* p)              { return __hip_atomic_load(p, __ATOMIC_RELAXED, __HIP_MEMORY_SCOPE_AGENT); }
__device__ __forceinline__ unsigned xb_add(unsigned* p, unsigned v) { return __hip_atomic_fetch_add(p, v, __ATOMIC_RELAXED, __HIP_MEMORY_SCOPE_AGENT); }
__device__ __forceinline__ unsigned xb_xcc_id() { return (unsigned)__builtin_amdgcn_s_getreg((3 << 11) | 20) & 0xFu; }
#define XB_SPIN(cond, bar) do { unsigned _sp = 0; while (cond) { __builtin_amdgcn_s_sleep(1); \
    if ((++_sp & 255u) == 0u) { if (xb_ld(&(bar)[XB_TMO])) break; if (_sp > XB_SPIN_CAP) { atomicAdd(&(bar)[XB_TMO], 1u); break; } } } } while (0)

struct XcdBarrier {
    unsigned* bar; unsigned x;
    volatile LAS unsigned* st;
};

__device__ __forceinline__ XcdBarrier xcd_barrier_post(unsigned* bar, volatile LAS unsigned* st) {
    XcdBarrier b; b.bar = bar; b.x = xb_xcc_id(); b.st = st;
    if (threadIdx.x == 0) (void)xb_add(&bar[XB_XCNT(b.x)], 1u);
    return b;
}
__device__ __forceinline__ void xcd_barrier_complete(unsigned* bar, unsigned x, unsigned& nloc, unsigned& nx) {
    const unsigned G = gridDim.x * gridDim.y * gridDim.z;
    unsigned sum, cnt, mine, sp = 0u;
    for (;;) {
        sum = 0u; cnt = 0u; mine = 0u;
#pragma unroll
        for (unsigned j = 0; j < 16; ++j) { const unsigned c = xb_ld(&bar[XB_XCNT(j)]); sum += c; cnt += (c > 0u) ? 1u : 0u; mine = (j == x) ? c : mine; }
        if (sum == G) break;
        __builtin_amdgcn_s_sleep(1);
        if ((++sp & 255u) == 0u) { if (xb_ld(&bar[XB_TMO])) break; if (sp > XB_SPIN_CAP) { atomicAdd(&bar[XB_TMO], 1u); break; } }
    }
    nloc = mine > 0u ? mine : 1u; nx = cnt > 0u ? cnt : 1u;
}

__device__ __forceinline__ void xcd_barrier(const XcdBarrier& b) {
    asm volatile("s_waitcnt vmcnt(0)" ::: "memory");
    __syncthreads();
    if (threadIdx.x == 0) {
        unsigned* bar = b.bar;
        __builtin_amdgcn_s_waitcnt(0);
        unsigned nloc = b.st[0], nx = b.st[1];
        if (nloc == 0u) { xcd_barrier_complete(bar, b.x, nloc, nx); b.st[0] = nloc; b.st[1] = nx; }
        const unsigned old = xb_add(&bar[XB_XSUB(b.x)], 1u);
        const unsigned gen = old / nloc;
        if (old + 1u == (gen + 1u) * nloc) {
            __builtin_amdgcn_fence(__ATOMIC_RELEASE, "agent");
            asm volatile("s_waitcnt vmcnt(0)" ::: "memory");
            const unsigned og = xb_add(&bar[XB_TOP], 1u);
            const unsigned tg = og / nx;
            if (og + 1u == (tg + 1u) * nx) xb_add(&bar[XB_TOPGEN], 1u);
            else XB_SPIN(xb_ld(&bar[XB_TOPGEN]) == tg, bar);
            __builtin_amdgcn_fence(__ATOMIC_ACQUIRE, "agent");
            xb_add(&bar[XB_XGEN(b.x)], 1u);
            asm volatile("s_waitcnt vmcnt(0)" ::: "memory");
        } else {
            XB_SPIN(xb_ld(&bar[XB_XGEN(b.x)]) == gen, bar);
            __builtin_amdgcn_fence(__ATOMIC_ACQUIRE, "agent");
            asm volatile("s_waitcnt vmcnt(0)" ::: "memory");
        }
    }
    __syncthreads();
}

__device__ __forceinline__ unsigned long long ldp(LAS unsigned long long* PT, int i) {
    const unsigned long long v = PT[i];
    const unsigned lo = __builtin_amdgcn_readfirstlane((unsigned)v), hi = __builtin_amdgcn_readfirstlane((unsigned)(v >> 32));
    return ((unsigned long long)hi << 32) | lo;
}
__device__ __forceinline__ void ffn_fixup(const pg8::StaticOrder& S, bf16_t* ACT, const float* Hfirst, const float* Hlast, const float* cw, const float* cb) {
    pg8::Unit u; int lastpm = -1;
    int t_ = threadIdx.x; asm volatile("" : "+v"(t_));
    for (int i = 0; S.next(i, u); ++i) {
        const int pm = u.pm; if (pm >= 256 || pm == lastpm) continue; lastpm = pm;
        const bool first = (pm & 7) == 0;
        const float* hl = Hlast + (size_t)((first ? pm : pm - 1) * 2) * FF2;
        const float* hf = Hfirst + (size_t)(pm * 2) * FF2;
        bf16_t* ab = ACT + (size_t)(pm * 256) * FF;
        for (unsigned f = (unsigned)t_; f < (unsigned)FF; f += 512u) {
            float yu[2], yg[2];
#pragma unroll
            for (int ug = 0; ug < 2; ++ug) {
                const unsigned col = (unsigned)(ug * FF) + f;
                const float P6 = first ? 0.f : hl[col], P7 = first ? 0.f : hl[FF2 + col];
                const float F0 = hf[col], F1 = hf[FF2 + col];
                const float w0 = cw[col], w1 = cw[FF2 + col], w2 = cw[2 * FF2 + col], bb = cb[col];
                const float y0 = bb + w0 * P6 + w1 * P7 + w2 * F0, y1 = bb + w0 * P7 + w1 * F0 + w2 * F1;
                if (ug == 0) { yu[0] = y0; yu[1] = y1; } else { yg[0] = y0; yg[1] = y1; }
            }
            ab[f] = f2bf(silu_f(yg[0]) * yu[0]);
            ab[FF + f] = f2bf(silu_f(yg[1]) * yu[1]);
        }
    }
    asm volatile("s_waitcnt vmcnt(0)" ::: "memory");
    __syncthreads();
}

__global__ void __launch_bounds__(512, 2) fwd(Args a) {
    extern __shared__ __attribute__((aligned(16))) unsigned char lds_[];
    LAS unsigned char* lds = (LAS unsigned char*)lds_;
    cg::grid_group grid = cg::this_grid();
    const int tid = threadIdx.x, lane = tid & 63, wave = __builtin_amdgcn_readfirstlane(tid >> 6);
    const int G = gridDim.x, bx = blockIdx.x;
    const int gw = bx * 8 + wave, NGW = G * 8;
    LAS unsigned long long* PT = (LAS unsigned long long*)(lds + PT_OFF);
    if (tid == 0) {
#pragma unroll
        for (int i = 0; i < 27; ++i) PT[i] = (unsigned long long)a.in[i];
        PT[27] = (unsigned long long)a.out; PT[28] = (unsigned long long)a.ws; PT[29] = (unsigned long long)(a.ws + WS_BAR);
        ((LAS unsigned*)(lds + PT_OFF + 240))[0] = 0u; ((LAS unsigned*)(lds + PT_OFF + 240))[1] = 0u;
    }
    __syncthreads();
    volatile LAS unsigned* xst = (volatile LAS unsigned*)(lds + PT_OFF + 240);
    (void)xcd_barrier_post((unsigned*)(a.ws + WS_BAR), xst);
#define GRID_SYNC() do { XcdBarrier b_; b_.bar = (unsigned*)ldp(PT, 29); b_.x = xb_xcc_id(); b_.st = xst; xcd_barrier(b_); } while (0)
#define GAS __attribute__((address_space(1)))
#define IN(i) ((const float*)(GAS const float*)ldp(PT, (i)))
#define OUTP ((float*)(GAS float*)ldp(PT, 27))
#define WSP(T, off) ((T*)(GAS T*)((GAS unsigned char*)ldp(PT, 28) + (off)))
#define mod WSP(float, WS_MOD)
#define shW WSP(float, WS_SHW)
#define ssq0 WSP(float, WS_SSQ)
#define ssq1 (WSP(float, WS_SSQ) + MTOT)
#define ssq2 (WSP(float, WS_SSQ) + 2 * MTOT)
#define ssq3 (WSP(float, WS_SSQ) + 3 * MTOT)
#define alow WSP(float, WS_ALOW)
#define Hf WSP(float, WS_HF)
#define Hl WSP(float, WS_HL)
#define Wgi WSP(bf16_t, WS_WGI)
#define Wgo WSP(bf16_t, WS_WGO)
#define Wdi WSP(bf16_t, WS_WDI)
#define Wdo WSP(bf16_t, WS_WDO)
#define WU(l) WSP(bf16_t, (l) == 0 ? WS_WU0 : WS_WU1)
#define WD(l) WSP(bf16_t, (l) == 0 ? WS_WD0 : WS_WD1)
#define XM WSP(bf16_t, WS_XM)
#define OB WSP(bf16_t, WS_O)
#define QKVR WSP(bf16_t, WS_QKVR)
#define ACT WSP(bf16_t, WS_QKVR)
#define KC WSP(bf16_t, WS_KC)
#define VC WSP(bf16_t, WS_VC)
#define out OUTP
#define mod0 mod
#define mod1 (mod + (size_t)NB * MODW)

    for (int rep_ = 0; rep_ < REP_P0; ++rep_)
    {
        for (int i = bx * 512 + tid; i < 3 * MTOT; i += G * 512) ssq1[i] = 0.f;
        LAS float* scr = (LAS float*)(lds + wave * 16384);
        for (int it = gw; it < 16 * 104; it += NGW) transpose_item(IN(I_GWIN), GIN, GIN, 1024, GIN_PAD, Wgi, 0, scr, it, lane);
        __syncthreads();
        const float* cp = IN(I_CP); const float* cs = IN(I_CS);
        for (int it = bx; it < 2 * 96; it += G) {
            const int layer = it / 96, cb = it % 96;
            sg48_item(IN(I_WADA) + (size_t)layer * 1024 * MODW, MODW, MODW, IN(I_BADA) + layer * MODW, mod + (size_t)layer * NB * MODW, MODW, 64 * cb,
                      [&](int b, int k) { const f32x4 c = *(const f32x4*)(b < 32 ? cp + b * 1024 + k : cs + (b - 32) * 1024 + k); return (f32x4){silu_f(c[0]), silu_f(c[1]), silu_f(c[2]), silu_f(c[3])}; }, lds);
        }
    }
    grid.sync();
    for (int rep_ = 0; rep_ < REP_P0; ++rep_)
    {
        for (int it = bx; it < 49; it += G) { const float* sh = mod; sg48_item(IN(I_GWIN), GIN, GIN, nullptr, shW + SHW_GLA, GIN_PAD, 64 * it, [&](int b, int k) { return *(const f32x4*)(sh + (size_t)b * MODW + k); }, lds); }
        const float* gain = IN(I_NMIX); const float* xp_ = IN(I_XP); const float* xs_ = IN(I_XS); const float* mod_ = mod; bf16_t* xm_ = XM; float* ssq0_ = ssq0;
        for (int row0_ = gw; row0_ < MTOT; row0_ += 2 * NGW) {
            f32x4 v[2][4]; const float* scp[2];
#pragma unroll
            for (int q = 0; q < 2; ++q) {
                const int row = (row0_ + q * NGW < MTOT) ? row0_ + q * NGW : row0_;
                const float* xr = row < MP ? xp_ + (size_t)row * DM : xs_ + (size_t)(row - MP) * DM;
                scp[q] = mod_ + (size_t)bidx_of(row) * MODW + 1024;
#pragma unroll
                for (int j = 0; j < 4; ++j) v[q][j] = *(const f32x4*)(xr + 4 * lane + 256 * j);
            }
#pragma unroll
            for (int q = 0; q < 2; ++q) {
                const int row = row0_ + q * NGW;
                if (row < MTOT) {
                    float s1 = 0.f;
#pragma unroll
                    for (int j = 0; j < 4; ++j) s1 += (v[q][j][0] * v[q][j][0] + v[q][j][1] * v[q][j][1]) + (v[q][j][2] * v[q][j][2] + v[q][j][3] * v[q][j][3]);
                    s1 = wave_sum(s1);
                    if (lane == 0) ssq0_[row] = s1;
#pragma unroll
                    for (int j = 0; j < 4; ++j) { const int col = 4 * lane + 256 * j; const f32x4 s = *(const f32x4*)(gain + col) * (*(const f32x4*)(scp[q] + col) + 1.f); const f32x4 z = v[q][j] * s;
                        *(u32x2*)(xm_ + (size_t)row * DM + col) = (u32x2){pk2(z[0], z[1]), pk2(z[2], z[3])}; }
                }
            }
        }
    }
    GRID_SYNC();
    for (int rep_ = 0; rep_ < REP_G; ++rep_)
    {
        pg8::Gemm g{XM, Wgi, MTOT, GIN_PAD, 1024}; pg8::StaticOrder S; S.init(MTOT, GIN_PAD, G, bx);
        EpiGlaIn E{QKVR, alow, ssq0, shW + SHW_GLA};
        pg8::gemm_phase<EpiGlaIn, pg8::StaticOrder, true, true, false>(lds, g, S, E, lds + XL_OFF);
    }
    GRID_SYNC();
    for (int rep_ = 0; rep_ < REP_P2; ++rep_)
    {
        if (bx < 128) { const int b = bx >> 2, h = bx & 3;
            gla_unit<64>(QKVR, alow, IN(I_GWAL), IN(I_GBAL), IN(I_GNORM), OB, b * 2048, 2048, h, nullptr, out + O_GSP + (size_t)(b * 4 + h) * 128 * 256, lds);
        } else if (bx < 192) { const int b = (bx - 128) >> 2, h = bx & 3;
            gla_unit<32>(QKVR, alow, IN(I_GWAL), IN(I_GBAL), IN(I_GNORM), OB, MP + b * 32, 32, h, IN(I_SGLA) + (size_t)(b * 4 + h) * 128 * 256, out + O_GSS + (size_t)(b * 4 + h) * 128 * 256, lds);
        }
        if (bx >= 128) {
            const int aw = bx - 128, NAW = G - 128;
            LAS float* scr = (LAS float*)(lds + wave * 16384);
            constexpr int I1 = 16 * 32, I2 = 16 * 96, I3 = 16 * 32, I4 = 16 * 176, I5 = 44 * 32;
            constexpr int NIT = I1 + I2 + I3 + 2 * I4 + 2 * I5;
            for (int it = aw * 8 + wave; it < NIT; it += NAW * 8) {
                int r = it;
                if (r < I1) { transpose_item(IN(I_GWOUT), 1024, 1024, 1024, 1024, Wgo, 0, scr, r, lane); continue; } r -= I1;
                if (r < I2) { transpose_item(IN(I_DWIN), DIN, DIN, 1024, DIN, Wdi, 2, scr, r, lane); continue; } r -= I2;
                if (r < I3) { transpose_item(IN(I_DWOUT), 1024, 1024, 1024, 1024, Wdo, 0, scr, r, lane); continue; } r -= I3;
                if (r < I4) { transpose_item(IN(I_FWIN), FF2, FF2, 1024, FF2, WU(0), 1, scr, r, lane); continue; } r -= I4;
                if (r < I4) { transpose_item(IN(I_FWIN) + (size_t)1024 * FF2, FF2, FF2, 1024, FF2, WU(1), 1, scr, r, lane); continue; } r -= I4;
                if (r < I5) { transpose_item(IN(I_FWOUT), 1024, 1024, FF, 1024, WD(0), 0, scr, r, lane); continue; } r -= I5;
                transpose_item(IN(I_FWOUT) + (size_t)FF * 1024, 1024, 1024, FF, 1024, WD(1), 0, scr, r, lane);
            }
            __syncthreads();
            for (int it = aw; it < 88 + 48 + 88; it += NAW) {
                int r = it;
                if (r < 88) { const float* sh = mod + 3072; sg48_item(IN(I_FWIN), FF2, FF2, nullptr, shW + SHW_UP0, FF2, 64 * r, [&](int b, int k) { return *(const f32x4*)(sh + (size_t)b * MODW + k); }, lds); continue; } r -= 88;
                if (r < 48) { const float* sh = mod + (size_t)NB * MODW; sg48_item(IN(I_DWIN), DIN, DIN, nullptr, shW + SHW_DIF, DIN, 64 * r, [&](int b, int k) { return *(const f32x4*)(sh + (size_t)b * MODW + k); }, lds); continue; } r -= 48;
                { const float* sh = mod + (size_t)NB * MODW + 3072; sg48_item(IN(I_FWIN) + (size_t)1024 * FF2, FF2, FF2, nullptr, shW + SHW_UP1, FF2, 64 * r, [&](int b, int k) { return *(const f32x4*)(sh + (size_t)b * MODW + k); }, lds); }
            }
            const size_t NCH = (size_t)16 * 2048 * 1024 / 8;
            for (int kv = 0; kv < 2; ++kv) {
                const float* srcb = kv ? IN(I_CV) : IN(I_CK); bf16_t* dstb = kv ? VC : KC;
                const size_t step = (size_t)NAW * 512;
                for (size_t i = (size_t)aw * 512 + tid; i < NCH; i += 4 * step) {
                    f32x4 x0[4], x1[4];
#pragma unroll
                    for (int q = 0; q < 4; ++q) { const size_t j = i + q * step; const float* src = srcb + (j < NCH ? j : i) * 8; x0[q] = *(const f32x4*)src; x1[q] = *(const f32x4*)(src + 4); }
#pragma unroll
                    for (int q = 0; q < 4; ++q) { const size_t j = i + q * step; if (j < NCH) *(u32x4*)(dstb + j * 8) = (u32x4){pk2(x0[q][0], x0[q][1]), pk2(x0[q][2], x0[q][3]), pk2(x1[q][0], x1[q][1]), pk2(x1[q][2], x1[q][3])}; }
                }
            }
        }
    }
    GRID_SYNC();
    {
        pg8::Gemm g{OB, Wgo, MP, 1024, 1024}; pg8::StaticOrder S; S.init(MP, 1024, G, bx);
        EpiRes E{IN(I_XP), IN(I_XS), out + O_Y, XM, ssq1, mod0 + 2048, mod0 + 4096, IN(I_NFFN), 0};
        for (int it = bx; it < 256; it += G) thin_res_item(OB, Wgo, 1024, it, E);
        pg8::gemm_phase<EpiRes, pg8::StaticOrder, true, true, false>(lds, g, S, E, lds + XL_OFF);
    }
    GRID_SYNC();
    {
        const float* modl = 0 == 0 ? mod0 : mod1;
        const float* cw = IN(I_FCW) + (size_t)0 * 3 * FF2; const float* cb = IN(I_FCB) + (size_t)0 * FF2;
    for (int rep_ = 0; rep_ < REP_U; ++rep_)
        {
            pg8::Gemm g{XM, WU(0), MTOT, FF2, 1024}; pg8::StaticOrder S; S.init(MTOT, FF2, G, bx);
            EpiUp E{ACT, Hf, Hl, 0 == 0 ? ssq1 : ssq3, shW + (0 == 0 ? SHW_UP0 : SHW_UP1), cw, cb, IN(I_SCONV) + (size_t)0 * 16 * 2 * FF2,
                    out + O_CP + (size_t)0 * 32 * 2 * FF2, out + O_CS + (size_t)0 * 16 * 2 * FF2};
            pg8::gemm_phase<EpiUp, pg8::StaticOrder, true, true, true>(lds, g, S, E, lds + XL_OFF);
        }
        GRID_SYNC();
        {
            pg8::Gemm g{ACT, WD(0), MP, 1024, FF}; pg8::StaticOrder S; S.init(MP, 1024, G, bx);
            ffn_fixup(S, ACT, Hf, Hl, cw, cb);
            EpiRes E{out + O_Y, out + O_Y + (size_t)MP * DM, out + O_Y, XM, ssq2, modl + 5120, mod1 + 1024, IN(I_NMIX) + 1024, 0};
            for (int it = bx; it < 256; it += G) thin_res_item(ACT, WD(0), FF, it, E);
            pg8::gemm_phase<EpiRes, pg8::StaticOrder, true, true, false>(lds, g, S, E, lds + XL_OFF);
        }
        GRID_SYNC();
    for (int rep_ = 0; rep_ < REP_G; ++rep_)
        {
            pg8::Gemm g{XM, Wdi, MTOT, DIN, 1024}; pg8::StaticOrder S; S.init(MTOT, DIN, G, bx);
            EpiDiffIn E{QKVR, QKVR + (size_t)MTOT * DM, QKVR + (size_t)2 * MTOT * DM, out + O_KP, out + O_KS, out + O_VP, out + O_VS, ssq2, shW + SHW_DIF, IN(I_DQN), IN(I_DKN)};
            pg8::gemm_phase<EpiDiffIn, pg8::StaticOrder, true, true, false>(lds, g, S, E, lds + XL_OFF);
        }
        GRID_SYNC();
    for (int rep_ = 0; rep_ < REP_A; ++rep_)
        {
            const float* dl = IN(I_DLAM);
            const float s1 = wave_sum(dl[lane] * dl[64 + lane]), s2 = wave_sum(dl[128 + lane] * dl[192 + lane]);
            const float lam = __expf(s1) - __expf(s2) + LAM_INIT1;
            AttnSrc A{QKVR, QKVR + (size_t)MTOT * DM, QKVR + (size_t)2 * MTOT * DM, KC, VC, OB, IN(I_DNORM)};
            const int vcu = (G % 8 == 0) ? (bx & 7) * (G >> 3) + (bx >> 3) : bx;
            for (int pi = vcu; pi < 2048; pi += G) {
                const int bh = pi >> 3, s = pi & 7;
                attn_unit(A, 0, bh >> 3, bh & 7, s, lam, lds);
                attn_unit(A, 0, bh >> 3, bh & 7, 15 - s, lam, lds);
            }
            for (int su = bx; su < 128; su += G) attn_unit(A, 1, su >> 3, su & 7, 0, lam, lds);
        }
        GRID_SYNC();
        {
            pg8::Gemm g{OB, Wdo, MP, 1024, 1024}; pg8::StaticOrder S; S.init(MP, 1024, G, bx);
            EpiRes E{out + O_Y, out + O_Y + (size_t)MP * DM, out + O_Y, XM, ssq3, mod1 + 2048, mod1 + 4096, IN(I_NFFN) + 1024, 0};
            for (int it = bx; it < 256; it += G) thin_res_item(OB, Wdo, 1024, it, E);
            pg8::gemm_phase<EpiRes, pg8::StaticOrder, true, true, false>(lds, g, S, E, lds + XL_OFF);
        }
        GRID_SYNC();
    }
    {
        const float* modl = 1 == 0 ? mod0 : mod1;
        const float* cw = IN(I_FCW) + (size_t)1 * 3 * FF2; const float* cb = IN(I_FCB) + (size_t)1 * FF2;
    for (int rep_ = 0; rep_ < 1; ++rep_)
        {
            pg8::Gemm g{XM, WU(1), MTOT, FF2, 1024}; pg8::StaticOrder S; S.init(MTOT, FF2, G, bx);
            EpiUp E{ACT, Hf, Hl, 1 == 0 ? ssq1 : ssq3, shW + (1 == 0 ? SHW_UP0 : SHW_UP1), cw, cb, IN(I_SCONV) + (size_t)1 * 16 * 2 * FF2,
                    out + O_CP + (size_t)1 * 32 * 2 * FF2, out + O_CS + (size_t)1 * 16 * 2 * FF2};
            pg8::gemm_phase<EpiUp, pg8::StaticOrder, true, true, true>(lds, g, S, E, lds + XL_OFF);
        }
        GRID_SYNC();
        {
            pg8::Gemm g{ACT, WD(1), MP, 1024, FF}; pg8::StaticOrder S; S.init(MP, 1024, G, bx);
            ffn_fixup(S, ACT, Hf, Hl, cw, cb);
            EpiRes E{out + O_Y, out + O_Y + (size_t)MP * DM, out + O_Y, XM, ssq2, modl + 5120, mod1 + 1024, IN(I_NMIX) + 1024, 1};
            for (int it = bx; it < 256; it += G) thin_res_item(ACT, WD(1), FF, it, E);
            pg8::gemm_phase<EpiRes, pg8::StaticOrder, true, true, false>(lds, g, S, E, lds + XL_OFF);
        }
    }
}

#undef out
#undef mod
extern "C" void kernel_launch(void* const* d_in, const int* in_sizes, int n_in, void* d_out, int out_size, void* d_ws, size_t ws_size, hipStream_t stream) {
    static int inited = 0;
    if (!inited) {
        (void)hipFuncSetAttribute((const void*)fwd, hipFuncAttributeMaxDynamicSharedMemorySize, LDS_BYTES);
        int per_cu = 0; (void)hipOccupancyMaxActiveBlocksPerMultiprocessor(&per_cu, (const void*)fwd, 512, LDS_BYTES);
        if (n_in != 27 || ws_size < WS_END || per_cu < 1) fprintf(stderr, "kernel_launch: n_in %d ws %zu per_cu %d out %d\n", n_in, ws_size, per_cu, out_size);
        inited = 1;
    }
    Args a{};
    for (int i = 0; i < 27; ++i) a.in[i] = (const float*)d_in[i];
    a.out = (float*)d_out; a.ws = (unsigned char*)d_ws;
    (void)hipMemsetAsync((unsigned char*)d_ws + WS_BAR, 0, 16384, stream);
    void* args[] = {&a};
    hipError_t e = hipLaunchCooperativeKernel((const void*)fwd, dim3(256), dim3(512), args, LDS_BYTES, stream);
    if (e != hipSuccess) fprintf(stderr, "cooperative launch failed: %s\n", hipGetErrorString(e));
}
```

```cpp
#include <hip/hip_runtime.h>
#include <hip/hip_cooperative_groups.h>
#include <cstdint>
#include <cstdio>
namespace cg = cooperative_groups;

#define LAS __attribute__((address_space(3)))
typedef short s16x4 __attribute__((ext_vector_type(4)));
typedef float f32x16 __attribute__((ext_vector_type(16)));
typedef unsigned u32x2 __attribute__((ext_vector_type(2)));
typedef float f32x2_t __attribute__((ext_vector_type(2)));
typedef __bf16 bf16x2_t __attribute__((ext_vector_type(2)));
typedef short v4i16_t __attribute__((ext_vector_type(4)));

constexpr int DM = 1024, MP = 65536, MS = 512, MTOT = MP + MS, NB = 48;
constexpr int GIN = 3088, GIN_PAD = 3328, FF = 2816, FF2 = 5632, DIN = 3072, MODW = 6144;
constexpr float EPS = 1e-6f;
constexpr float LAM_INIT1 = 0.35550906759f;
constexpr float QSCALE = 0.125f * 1.4426950408889634f;
constexpr float GLA_QSC = 0.08838834764831845f;

constexpr size_t O_Y = 0, O_GSP = 67633152, O_GSS = 71827456, O_KP = 73924608, O_KS = 141033472, O_VP = 141557760, O_VS = 208666624, O_CP = 209190912, O_CS = 209911808;

constexpr size_t MiB = 1u << 20;
constexpr size_t WS_BAR = 2621440;
constexpr size_t WS_MOD = 0, WS_SHW = 3 * MiB, WS_SSQ = 7 * MiB, WS_ALOW = 9 * MiB, WS_HF = 14 * MiB, WS_HL = 26 * MiB;
constexpr size_t WS_WGI = 38 * MiB, WS_WGO = 45 * MiB, WS_WDI = 47 * MiB, WS_WDO = 53 * MiB, WS_WU0 = 55 * MiB, WS_WU1 = 66 * MiB, WS_WD0 = 77 * MiB, WS_WD1 = 83 * MiB;
constexpr size_t WS_XM = 90 * MiB, WS_O = 220 * MiB, WS_QKVR = 350 * MiB, WS_KC = 738 * MiB, WS_VC = 802 * MiB, WS_END = 866 * MiB;
constexpr size_t SHW_GLA = 0, SHW_UP0 = (size_t)NB * GIN_PAD, SHW_DIF = SHW_UP0 + (size_t)NB * FF2, SHW_UP1 = SHW_DIF + (size_t)NB * DIN;

constexpr int XL_OFF = 131072;
constexpr int LDS_BYTES = 163840;
constexpr int PT_OFF = 163584;

__device__ __forceinline__ unsigned pk2(float lo, float hi) { f32x2_t v = {lo, hi}; bf16x2_t b = __builtin_convertvector(v, bf16x2_t); return __builtin_bit_cast(unsigned, b); }
__device__ __forceinline__ float bflo(unsigned u) { return __uint_as_float(u << 16); }
__device__ __forceinline__ float bfhi(unsigned u) { return __uint_as_float(u & 0xffff0000u); }
__device__ __forceinline__ float bf2f(unsigned short u) { return __uint_as_float(((unsigned)u) << 16); }
__device__ __forceinline__ unsigned short f2bf(float f) { return (unsigned short)(pk2(f, 0.f) & 0xffffu); }
__device__ __forceinline__ float silu_f(float x) { return x * __builtin_amdgcn_rcpf(1.f + __expf(-x)); }
__device__ __forceinline__ int bidx_of(int row) { return row < MP ? (row >> 11) : 32 + ((row - MP) >> 5); }
__device__ __forceinline__ int crow(int r, int hi) { return (r & 3) + 8 * (r >> 2) + 4 * hi; }
__device__ __forceinline__ float wave_sum(float v) {
#pragma unroll
    for (int o = 1; o < 64; o <<= 1) v += __shfl_xor(v, o);
    return v;
}
#define MFMA32(a, b, c) __builtin_amdgcn_mfma_f32_32x32x16_bf16((a), (b), (c), 0, 0, 0)

namespace pg8 {
#define PG8_LAS __attribute__((address_space(3)))
typedef unsigned short bf16_t;
typedef short bf16x8 __attribute__((ext_vector_type(8)));
typedef float f32x4 __attribute__((ext_vector_type(4)));
typedef unsigned u32x4 __attribute__((ext_vector_type(4)));
constexpr int BM = 256, BK = 64, HALF = 128, HTB = HALF * BK * 2  , STAGE_BYTES = 8 * HTB, NXCD = 8, WGM = 8;

__host__ __device__ __forceinline__ int lds_byte(int r, int c) { const int st = (r >> 4) * 2 + (c >> 5), rr = r & 15, cc = c & 31, ob = rr * 64 + cc * 2; return st * 1024 + (ob ^ (((ob >> 9) & 1) << 5)); }
__host__ __device__ __forceinline__ void stage_rc(int b, int& R, int& C) { const int st = b / 1024, sb = b % 1024, swz = sb ^ (((sb >> 9) & 1) << 5); R = (st >> 1) * 16 + swz / 64; C = (st & 1) * 32 + (swz % 64) / 2; }
__host__ __device__ __forceinline__ int perm32(int rho) { const int n = rho >> 4, i = rho & 15; return 8 * (i >> 2) + 4 * n + (i & 3); }

struct Unit { int pm, pn; };
struct Gemm { const bf16_t* A; const bf16_t* Bt; int M, N, K; };

struct StaticOrder {
    int nM, nN, nwg, G, c;
    __host__ __device__ void init(int M, int N, int G_, int c_) { nM = M / BM; nN = N / BM; nwg = nM * nN; G = G_; c = c_; }
    __host__ __device__ bool next(int i, Unit& u) const {
        const long L = (long)i * G + c; if (L >= nwg) return false;
        int wgid = (int)L; { const int q = nwg / NXCD, r = nwg % NXCD, xcd = wgid % NXCD, off = wgid / NXCD; wgid = (xcd < r ? xcd * (q + 1) : r * (q + 1) + (xcd - r) * q) + off; }
        const int nig = WGM * nN, gid = wgid / nig, fm = gid * WGM, gsz = (nM - fm) < WGM ? (nM - fm) : WGM;
        u.pm = fm + ((wgid % nig) % gsz); u.pn = (wgid % nig) / gsz; return true;
    }
    __device__ __forceinline__ void a_ready(const Unit&) const {}
    __device__ __forceinline__ void done(const Unit&) const {}
};

template <class Epi, class Sched, bool ALIGN_EPI, bool SP2, bool ROWPERM>
__device__ __forceinline__ void gemm_phase(PG8_LAS unsigned char* lds, const Gemm g, const Sched& S, const Epi& E, PG8_LAS unsigned char* xl) {
    int tid_ = threadIdx.x; asm volatile("" : "+v"(tid_));
    const int tid = tid_, wid = __builtin_amdgcn_readfirstlane(tid >> 6), lane = tid & 63, wr = wid >> 2, wc = wid & 3, fr = lane & 15, fq = lane >> 4;
    const int K = g.K, nt = K / BK;
    unsigned voffA[2], voffB[2];
#pragma unroll
    for (int i = 0; i < 2; ++i) { int R, C; stage_rc(tid * 16 + i * 8192, R, C); const int Rb = Epi::PERM ? ((R & ~31) + perm32(R & 31)) : R;
        const int Ra = ROWPERM ? (((R >> 6) & 1) * 128 + (R & 15) * 8 + ((R >> 4) & 3)) : R;
        voffA[i] = (unsigned)(Ra * K + C) * 2u; voffB[i] = (unsigned)(Rb * K + C) * 2u; }
    const size_t kstep = (size_t)(BK * 2);
    const size_t hstep = (size_t)HALF * K * 2; const size_t hstepA = ROWPERM ? (size_t)4 * K * 2 : hstep;
    const size_t tstep = 2 * hstep;
    const unsigned ldsw = (unsigned)wid * 1024u;
    const int aoff = lds_byte(wr * 64 + fr, fq * 8), boff = lds_byte(wc * 32 + fr, fq * 8);
#define PG8_SA(b, h) (((b) * 2 + (h)) * HTB)
#define PG8_SB(b, h) ((4 + (b) * 2 + (h)) * HTB)
#define PG8_STAGE(bufoff, gbase, voff) do { _Pragma("unroll") for (int _i = 0; _i < 2; ++_i) \
        __builtin_amdgcn_global_load_lds((const unsigned*)((const char*)(gbase) + (voff)[_i]), (PG8_LAS unsigned*)(lds + (bufoff) + ldsw + _i * 8192), 16, 0, 0); } while (0)
#define PG8_LDA(dst, b, h) do { _Pragma("unroll") for (int m = 0; m < 4; ++m) _Pragma("unroll") for (int k = 0; k < 2; ++k) dst[m][k] = *(const PG8_LAS bf16x8*)(lds + PG8_SA(b, h) + aoff + m * 2048 + k * 1024); } while (0)
#define PG8_LDB(dst, b, h) do { _Pragma("unroll") for (int n = 0; n < 2; ++n) _Pragma("unroll") for (int k = 0; k < 2; ++k) dst[n][k] = *(const PG8_LAS bf16x8*)(lds + PG8_SB(b, h) + boff + n * 2048 + k * 1024); } while (0)
#define PG8_MMA(ai, bj, At, Bt) do { __builtin_amdgcn_s_setprio(1); _Pragma("unroll") for (int m = 0; m < 4; ++m) _Pragma("unroll") for (int n = 0; n < 2; ++n) _Pragma("unroll") for (int k = 0; k < 2; ++k) \
        acc[ai][bj][m][n] = __builtin_amdgcn_mfma_f32_16x16x32_bf16(Bt[n][k], At[m][k], acc[ai][bj][m][n], 0, 0, 0); __builtin_amdgcn_s_setprio(0); } while (0)
#define PG8_WAIT_V(n) asm volatile("s_waitcnt vmcnt(" #n ")" ::: "memory")
#define PG8_WAIT_L(n) asm volatile("s_waitcnt lgkmcnt(" #n ")" ::: "memory")
#define PG8_BAR __builtin_amdgcn_s_barrier()
#define PG8_SCHED __builtin_amdgcn_sched_barrier(0)
    Unit cur, nxt; int ui = 0;
    if (!S.next(0, cur)) return;
    f32x4 acc[2][2][4][2];
#pragma unroll
    for (int a = 0; a < 2; ++a)
#pragma unroll
        for (int b = 0; b < 2; ++b)
#pragma unroll
            for (int m = 0; m < 4; ++m)
#pragma unroll
                for (int n = 0; n < 2; ++n) acc[a][b][m][n] = (f32x4){0.f, 0.f, 0.f, 0.f};
    bf16x8 At[4][2], B0[2][2], B1[2][2];
    const char* cA = (const char*)g.A + (size_t)cur.pm * tstep; const char* cB = (const char*)g.Bt + (size_t)cur.pn * tstep;

    if constexpr (SP2) {
        PG8_STAGE(PG8_SB(0, 0), cB, voffB); PG8_STAGE(PG8_SB(0, 1), cB + hstep, voffB); PG8_STAGE(PG8_SA(0, 0), cA, voffA); PG8_STAGE(PG8_SA(0, 1), cA + hstepA, voffA);
        if (wr == 1) PG8_BAR;
        PG8_WAIT_V(2); PG8_BAR;
        PG8_STAGE(PG8_SB(1, 0), cB + kstep, voffB); PG8_STAGE(PG8_SA(1, 0), cA + kstep, voffA); PG8_STAGE(PG8_SB(1, 1), cB + hstep + kstep, voffB);
        PG8_WAIT_V(6); PG8_BAR;
    } else {
        PG8_STAGE(PG8_SB(0, 0), cB, voffB); PG8_STAGE(PG8_SA(0, 0), cA, voffA); PG8_STAGE(PG8_SB(0, 1), cB + hstep, voffB); PG8_STAGE(PG8_SA(0, 1), cA + hstepA, voffA);
        if (wr == 1) PG8_BAR;
        PG8_WAIT_V(4); PG8_BAR;
        PG8_STAGE(PG8_SB(1, 0), cB + kstep, voffB); PG8_STAGE(PG8_SA(1, 0), cA + kstep, voffA); PG8_STAGE(PG8_SB(1, 1), cB + hstep + kstep, voffB);
        PG8_WAIT_V(6); PG8_BAR;
    }
    for (;;) {
        const bool has_next = S.next(ui + 1, nxt);
        const char* nA = has_next ? (const char*)g.A + (size_t)nxt.pm * tstep : cA; const char* nB = has_next ? (const char*)g.Bt + (size_t)nxt.pn * tstep : cB;
        for (int t = 0; t < nt; t += 2) {
            const bool last = (t == nt - 2);
            const char* a1 = cA + (size_t)(t + 1) * kstep;
            const char* a2 = last ? nA : cA + (size_t)(t + 2) * kstep; const char* b2 = last ? nB : cB + (size_t)(t + 2) * kstep;
            const char* a3 = a2 + kstep; const char* b3 = b2 + kstep;

            if constexpr (SP2) {
            PG8_LDB(B0, 0, 0); PG8_LDB(B1, 0, 1); PG8_SCHED; PG8_LDA(At, 0, 0); PG8_STAGE(PG8_SA(1, 1), a1 + hstepA, voffA);
            PG8_WAIT_V(8); PG8_WAIT_L(0); PG8_BAR; PG8_MMA(0, 0, At, B0); PG8_MMA(0, 1, At, B1); PG8_BAR; PG8_SCHED;
            PG8_LDA(At, 0, 1); PG8_STAGE(PG8_SB(0, 0), b2, voffB); PG8_STAGE(PG8_SB(0, 1), b2 + hstep, voffB); PG8_STAGE(PG8_SA(0, 0), a2, voffA);
            PG8_WAIT_V(8); PG8_WAIT_L(0); PG8_BAR; PG8_MMA(1, 0, At, B0); PG8_MMA(1, 1, At, B1); PG8_BAR; PG8_SCHED;
            PG8_LDB(B0, 1, 0); PG8_LDB(B1, 1, 1); PG8_SCHED; PG8_LDA(At, 1, 0); PG8_STAGE(PG8_SA(0, 1), a2 + hstepA, voffA);
            PG8_WAIT_V(8); PG8_WAIT_L(0); PG8_BAR; PG8_MMA(0, 0, At, B0); PG8_MMA(0, 1, At, B1); PG8_BAR; PG8_SCHED;
            PG8_LDA(At, 1, 1); PG8_STAGE(PG8_SB(1, 0), b3, voffB); PG8_STAGE(PG8_SB(1, 1), b3 + hstep, voffB); PG8_STAGE(PG8_SA(1, 0), a3, voffA);
            PG8_WAIT_V(8); PG8_WAIT_L(0); PG8_BAR; PG8_MMA(1, 0, At, B0); PG8_MMA(1, 1, At, B1); PG8_BAR; PG8_SCHED;
            } else {
            PG8_LDB(B0, 0, 0); PG8_SCHED; PG8_LDA(At, 0, 0); PG8_STAGE(PG8_SA(1, 1), a1 + hstepA, voffA);
            PG8_WAIT_L(8); PG8_BAR; PG8_WAIT_L(0); PG8_MMA(0, 0, At, B0); PG8_BAR; PG8_SCHED;
            PG8_LDB(B1, 0, 1); PG8_STAGE(PG8_SB(0, 0), b2, voffB);
            PG8_BAR; PG8_WAIT_L(0); PG8_MMA(0, 1, At, B1); PG8_BAR;
            PG8_LDA(At, 0, 1); PG8_STAGE(PG8_SA(0, 0), a2, voffA);
            PG8_BAR; PG8_WAIT_L(0); PG8_MMA(1, 0, At, B0); PG8_BAR; PG8_SCHED;
            PG8_STAGE(PG8_SB(0, 1), b2 + hstep, voffB);
            PG8_WAIT_V(6); PG8_BAR; PG8_MMA(1, 1, At, B1); PG8_BAR;
            PG8_LDB(B0, 1, 0); PG8_SCHED; PG8_LDA(At, 1, 0); PG8_STAGE(PG8_SA(0, 1), a2 + hstepA, voffA);
            PG8_WAIT_L(8); PG8_BAR; PG8_WAIT_L(0); PG8_MMA(0, 0, At, B0); PG8_BAR; PG8_SCHED;
            PG8_LDB(B1, 1, 1); PG8_STAGE(PG8_SB(1, 0), b3, voffB);
            PG8_BAR; PG8_WAIT_L(0); PG8_MMA(0, 1, At, B1); PG8_BAR;
            PG8_LDA(At, 1, 1); PG8_STAGE(PG8_SA(1, 0), a3, voffA);
            PG8_BAR; PG8_WAIT_L(0); PG8_MMA(1, 0, At, B0); PG8_BAR; PG8_SCHED;
            PG8_STAGE(PG8_SB(1, 1), b3 + hstep, voffB);
            PG8_WAIT_V(6); PG8_BAR; PG8_MMA(1, 1, At, B1); PG8_BAR;
            }
        }
        if constexpr (ALIGN_EPI) { if (wr == 0) PG8_BAR; }
        E(acc, cur, wr, wc, fr, fq, xl);
        if (!has_next) break;
#pragma unroll
        for (int a = 0; a < 2; ++a)
#pragma unroll
            for (int b = 0; b < 2; ++b)
#pragma unroll
                for (int m = 0; m < 4; ++m)
#pragma unroll
                    for (int n = 0; n < 2; ++n) acc[a][b][m][n] = (f32x4){0.f, 0.f, 0.f, 0.f};
        cur = nxt; cA = nA; cB = nB; ++ui;
        if constexpr (ALIGN_EPI) { if (wr == 1) PG8_BAR; }
    }
    PG8_WAIT_V(0);
    if constexpr (!ALIGN_EPI) { if (wr == 0) PG8_BAR; }
    PG8_BAR;
#undef PG8_SA
#undef PG8_SB
#undef PG8_STAGE
#undef PG8_LDA
#undef PG8_LDB
#undef PG8_MMA
#undef PG8_WAIT_V
#undef PG8_WAIT_L
#undef PG8_BAR
#undef PG8_SCHED
}
}

using pg8::bf16_t; using pg8::bf16x8; using pg8::f32x4; using pg8::u32x4;
typedef const f32x4 (&AccRef)[2][2][4][2];

struct EpiGlaIn {
    static constexpr bool PERM = true;
    bf16_t* QKVR; float* alow; const float* ssq; const float* shW;
    __device__ __forceinline__ void operator()(AccRef acc, const pg8::Unit& u, int wr, int wc, int fr, int fq, LAS unsigned char*) const {
        const int colt = u.pn * 256 + wc * 32 + 8 * fq;
#pragma unroll
        for (int ai = 0; ai < 2; ++ai)
#pragma unroll
            for (int m = 0; m < 4; ++m) {
                const int row = u.pm * 256 + ai * 128 + wr * 64 + m * 16 + fr; const int b = bidx_of(row);
                const float rs = rsqrtf(ssq[row] * (1.f / 1024.f) + EPS);
#pragma unroll
                for (int bj = 0; bj < 2; ++bj) {
                    const int col = colt + bj * 128;
                    const f32x4 b0 = *(const f32x4*)(shW + (size_t)b * GIN_PAD + col), b1 = *(const f32x4*)(shW + (size_t)b * GIN_PAD + col + 4);
                    const f32x4 v0 = acc[ai][bj][m][0] * rs + b0, v1 = acc[ai][bj][m][1] * rs + b1;
                    if (u.pn < 12) { u32x4 w; w.x = pk2(v0[0], v0[1]); w.y = pk2(v0[2], v0[3]); w.z = pk2(v1[0], v1[1]); w.w = pk2(v1[2], v1[3]); *(u32x4*)(QKVR + (size_t)row * 3072 + col) = w; }
                    else if (col < GIN) { float* p = alow + (size_t)row * 16 + (col - 3072); *(f32x4*)p = v0; *(f32x4*)(p + 4) = v1; }
                }
            }
    }
};

struct EpiRes {
    static constexpr bool PERM = true;
    const float* xin_p; const float* xin_s; float* xout; bf16_t* XM; float* ssq_out; const float* gt; const float* sc; const float* gain; int last;
    __device__ __forceinline__ void operator()(AccRef acc, const pg8::Unit& u, int wr, int wc, int fr, int fq, LAS unsigned char*) const {
        const int colt = u.pn * 256 + wc * 32 + 8 * fq;
#pragma unroll
        for (int ai = 0; ai < 2; ++ai)
#pragma unroll
            for (int m = 0; m < 4; ++m) {
                const int row = u.pm * 256 + ai * 128 + wr * 64 + m * 16 + fr; const int b = bidx_of(row);
                const float* xin = row < MP ? xin_p + (size_t)row * DM : xin_s + (size_t)(row - MP) * DM;
                float ss = 0.f;
#pragma unroll
                for (int bj = 0; bj < 2; ++bj) {
                    const int col = colt + bj * 128;
                    const f32x4 g0 = *(const f32x4*)(gt + (size_t)b * MODW + col), g1 = *(const f32x4*)(gt + (size_t)b * MODW + col + 4);
                    const f32x4 x0 = *(const f32x4*)(xin + col), x1 = *(const f32x4*)(xin + col + 4);
                    const f32x4 y0 = x0 + g0 * acc[ai][bj][m][0], y1 = x1 + g1 * acc[ai][bj][m][1];
                    float* op = xout + (size_t)row * DM + col;
                    if (last) { __builtin_nontemporal_store(y0, (f32x4*)op); __builtin_nontemporal_store(y1, (f32x4*)(op + 4)); } else { *(f32x4*)op = y0; *(f32x4*)(op + 4) = y1; }
                    if (!last) {
                        const f32x4 s0 = *(const f32x4*)(gain + col) * (*(const f32x4*)(sc + (size_t)b * MODW + col) + 1.f), s1 = *(const f32x4*)(gain + col + 4) * (*(const f32x4*)(sc + (size_t)b * MODW + col + 4) + 1.f);
                        const f32x4 z0 = y0 * s0, z1 = y1 * s1;
                        u32x4 w; w.x = pk2(z0[0], z0[1]); w.y = pk2(z0[2], z0[3]); w.z = pk2(z1[0], z1[1]); w.w = pk2(z1[2], z1[3]);
                        *(u32x4*)(XM + (size_t)row * DM + col) = w;
                        ss += (y0[0] * y0[0] + y0[1] * y0[1]) + (y0[2] * y0[2] + y0[3] * y0[3]) + (y1[0] * y1[0] + y1[1] * y1[1]) + (y1[2] * y1[2] + y1[3] * y1[3]);
                    }
                }
                if (!last) { ss += __shfl_xor(ss, 16); ss += __shfl_xor(ss, 32); if (fq == 0) atomicAdd(ssq_out + row, ss); }
            }
    }
};


__device__ __forceinline__ void thin_res_item(const bf16_t* A, const bf16_t* Bt, int K, int item, const EpiRes& E) {
    int tid_ = threadIdx.x; asm volatile("" : "+v"(tid_));
    const int tid = tid_, lane = tid & 63, wave = __builtin_amdgcn_readfirstlane(tid >> 6), fr = lane & 15, fq = lane >> 4;
    const int rg = item >> 3, cg = item & 7, n0 = cg * 128 + wave * 16;
    const int row = MP + rg * 16 + fr;
    const bf16_t* ap = A + (size_t)(MP + rg * 16) * K;
    const bf16_t* bp = Bt + (size_t)n0 * K;
    const unsigned lo = (unsigned)(fr * K + 8 * fq);
    f32x4 acc = {0.f, 0.f, 0.f, 0.f};
#pragma unroll 8
    for (int k0 = 0; k0 < K; k0 += 32) {
        const bf16x8 a = *(const bf16x8*)(ap + lo + k0), b = *(const bf16x8*)(bp + lo + k0);
        acc = __builtin_amdgcn_mfma_f32_16x16x32_bf16(b, a, acc, 0, 0, 0);
    }
    const int col = n0 + 4 * fq; const int bb = bidx_of(row);
    const float* xin = E.xin_s + (size_t)(row - MP) * DM;
    const f32x4 g = *(const f32x4*)(E.gt + (size_t)bb * MODW + col), x = *(const f32x4*)(xin + col);
    const f32x4 y = x + g * acc;
    *(f32x4*)(E.xout + (size_t)row * DM + col) = y;
    if (!E.last) {
        const f32x4 s = *(const f32x4*)(E.gain + col) * (*(const f32x4*)(E.sc + (size_t)bb * MODW + col) + 1.f), z = y * s;
        *(u32x2*)(E.XM + (size_t)row * DM + col) = (u32x2){pk2(z[0], z[1]), pk2(z[2], z[3])};
        float ss = (y[0] * y[0] + y[1] * y[1]) + (y[2] * y[2] + y[3] * y[3]);
        ss += __shfl_xor(ss, 16); ss += __shfl_xor(ss, 32);
        if (fq == 0) atomicAdd(E.ssq_out + row, ss);
    }
}

struct EpiUp {
    static constexpr bool PERM = true;
    bf16_t* ACT; float* Hfirst; float* Hlast; const float* ssq; const float* shW; const float* cw; const float* cb; const float* cstate; float* ncp; float* ncs;
    __device__ __forceinline__ void operator()(AccRef acc, const pg8::Unit& u, int wr, int wc, int fr, int fq, LAS unsigned char* xl) const {
        const int pm = u.pm, f0 = u.pn * 128 + wc * 32 + 8 * fq, toff = wr * 128 + fr * 8, row0 = pm * 256 + toff;
        const bool samp = pm >= 256;
        const int b = samp ? 32 + (pm - 256) * 8 + (toff >> 5) : (pm >> 3);
        const bool defer = !samp && wr == 0 && fr == 0, lastlane = !samp && wr == 1 && fr == 15, seqstart = samp && (fr & 3) == 0;
        float rs[8];
        { const f32x4 q0 = *(const f32x4*)(ssq + row0), q1 = *(const f32x4*)(ssq + row0 + 4);
#pragma unroll
          for (int j = 0; j < 4; ++j) { rs[j] = rsqrtf(q0[j] * (1.f / 1024.f) + EPS); rs[4 + j] = rsqrtf(q1[j] * (1.f / 1024.f) + EPS); } }
        const float* shb = shW + (size_t)b * FF2;
        LAS float* xf = (LAS float*)xl + (wc * 4 + fq) * 32;
        if (wr == 0 && fr == 15) {
#pragma unroll
            for (int n = 0; n < 2; ++n) {
                const f32x4 bu = *(const f32x4*)(shb + f0 + 4 * n), bg = *(const f32x4*)(shb + FF + f0 + 4 * n);
                *(LAS f32x4*)(xf + 0 + n * 4) = acc[1][0][2][n] * rs[6] + bu; *(LAS f32x4*)(xf + 8 + n * 4) = acc[1][1][2][n] * rs[6] + bg;
                *(LAS f32x4*)(xf + 16 + n * 4) = acc[1][0][3][n] * rs[7] + bu; *(LAS f32x4*)(xf + 24 + n * 4) = acc[1][1][3][n] * rs[7] + bg;
            }
        }
        asm volatile("s_waitcnt lgkmcnt(0)\n\ts_barrier" ::: "memory");
#pragma unroll
        for (int n = 0; n < 2; ++n) {
            const int fc = f0 + 4 * n;
            const f32x4 bu = *(const f32x4*)(shb + fc), bg = *(const f32x4*)(shb + FF + fc);
            const f32x4 w0u = *(const f32x4*)(cw + fc), w1u = *(const f32x4*)(cw + FF2 + fc), w2u = *(const f32x4*)(cw + 2 * FF2 + fc), cbu = *(const f32x4*)(cb + fc);
            const f32x4 w0g = *(const f32x4*)(cw + FF + fc), w1g = *(const f32x4*)(cw + FF2 + FF + fc), w2g = *(const f32x4*)(cw + 2 * FF2 + FF + fc), cbg = *(const f32x4*)(cb + FF + fc);
            f32x4 p2u, p1u, p2g, p1g;
            {
                const f32x4 u6 = acc[1][0][2][n] * rs[6] + bu, g6 = acc[1][1][2][n] * rs[6] + bg, u7 = acc[1][0][3][n] * rs[7] + bu, g7 = acc[1][1][3][n] * rs[7] + bg;
#pragma unroll
                for (int c = 0; c < 4; ++c) { p2u[c] = __shfl_up(u6[c], 1, 16); p1u[c] = __shfl_up(u7[c], 1, 16); p2g[c] = __shfl_up(g6[c], 1, 16); p1g[c] = __shfl_up(g7[c], 1, 16); }
            }
            if (seqstart) {
                const float* st = cstate + (size_t)(b - 32) * 2 * FF2;
                p2u = *(const f32x4*)(st + fc); p2g = *(const f32x4*)(st + FF + fc); p1u = *(const f32x4*)(st + FF2 + fc); p1g = *(const f32x4*)(st + FF2 + FF + fc);
            } else if (fr == 0 && wr == 1) {
                p2u = *(LAS f32x4*)(xf + 0 + n * 4); p2g = *(LAS f32x4*)(xf + 8 + n * 4); p1u = *(LAS f32x4*)(xf + 16 + n * 4); p1g = *(LAS f32x4*)(xf + 24 + n * 4);
            }
#pragma unroll
            for (int j = 0; j < 8; ++j) {
                const int ai = j >> 2, m = j & 3;
                const f32x4 cu = acc[ai][0][m][n] * rs[j] + bu, cg = acc[ai][1][m][n] * rs[j] + bg;
                if (defer && j < 2) {
                    float* hp = Hfirst + (size_t)(pm * 2 + j) * FF2; *(f32x4*)(hp + fc) = cu; *(f32x4*)(hp + FF + fc) = cg;
                } else {
                    const f32x4 yu = cbu + w0u * p2u + w1u * p1u + w2u * cu, yg = cbg + w0g * p2g + w1g * p1g + w2g * cg;
                    u32x2 w; w.x = pk2(silu_f(yg[0]) * yu[0], silu_f(yg[1]) * yu[1]); w.y = pk2(silu_f(yg[2]) * yu[2], silu_f(yg[3]) * yu[3]);
                    *(u32x2*)(ACT + (size_t)(row0 + j) * FF + fc) = w;
                }
                if (j >= 6) {
                    if (lastlane) { float* hp = Hlast + (size_t)(pm * 2 + (j - 6)) * FF2; *(f32x4*)(hp + fc) = cu; *(f32x4*)(hp + FF + fc) = cg;
                        if ((pm & 7) == 7) { float* cp = ncp + (size_t)((pm >> 3) * 2 + (j - 6)) * FF2; *(f32x4*)(cp + fc) = cu; *(f32x4*)(cp + FF + fc) = cg; } }
                    if (samp && (fr & 3) == 3) { float* cp = ncs + (size_t)((b - 32) * 2 + (j - 6)) * FF2; *(f32x4*)(cp + fc) = cu; *(f32x4*)(cp + FF + fc) = cg; }
                }
                p2u = p1u; p2g = p1g; p1u = cu; p1g = cg;
            }
        }
    }
};

struct EpiDiffIn {
    static constexpr bool PERM = true;
    bf16_t* Qb; bf16_t* Kb; bf16_t* Vb; float* nkp; float* nks; float* nvp; float* nvs; const float* ssq; const float* shW; const float* qg; const float* kg;
    __device__ __forceinline__ void operator()(AccRef acc, const pg8::Unit& u, int wr, int wc, int fr, int fq, LAS unsigned char*) const {
        const int pn = u.pn;
#pragma unroll
        for (int ai = 0; ai < 2; ++ai)
#pragma unroll
            for (int m = 0; m < 4; ++m) {
                const int row = u.pm * 256 + ai * 128 + wr * 64 + m * 16 + fr; const int b = bidx_of(row);
                const float rs = rsqrtf(ssq[row] * (1.f / 1024.f) + EPS);
                const float* shb = shW + (size_t)b * DIN;
                if (pn < 8) {
                    const int cg0 = pn * 256 + wc * 64 + 8 * fq;
                    f32x4 v[2][2]; float ss = 0.f;
#pragma unroll
                    for (int bj = 0; bj < 2; ++bj)
#pragma unroll
                        for (int n = 0; n < 2; ++n) { v[bj][n] = acc[ai][bj][m][n] * rs + *(const f32x4*)(shb + cg0 + 32 * bj + 4 * n);
                            ss += (v[bj][n][0] * v[bj][n][0] + v[bj][n][1] * v[bj][n][1]) + (v[bj][n][2] * v[bj][n][2] + v[bj][n][3] * v[bj][n][3]); }
                    ss += __shfl_xor(ss, 16); ss += __shfl_xor(ss, 32);
                    const float r2 = rsqrtf(ss * (1.f / 64.f) + EPS) * (pn < 4 ? QSCALE : 1.f);
                    const float* gp = (pn < 4 ? qg : kg) + 8 * fq;
#pragma unroll
                    for (int bj = 0; bj < 2; ++bj) {
                        const f32x4 o0 = v[bj][0] * r2 * *(const f32x4*)(gp + 32 * bj), o1 = v[bj][1] * r2 * *(const f32x4*)(gp + 32 * bj + 4);
                        u32x4 w; w.x = pk2(o0[0], o0[1]); w.y = pk2(o0[2], o0[3]); w.z = pk2(o1[0], o1[1]); w.w = pk2(o1[2], o1[3]);
                        const int col = cg0 + 32 * bj;
                        if (pn < 4) *(u32x4*)(Qb + (size_t)row * DM + col) = w;
                        else { const int kc = col - 1024; *(u32x4*)(Kb + (size_t)row * DM + kc) = w;
                            float* op = (row < MP ? nkp + (size_t)row * DM : nks + (size_t)(row - MP) * DM) + kc; __builtin_nontemporal_store(o0, (f32x4*)op); __builtin_nontemporal_store(o1, (f32x4*)(op + 4)); }
                    }
                } else {
#pragma unroll
                    for (int bj = 0; bj < 2; ++bj) {
                        const int col = pn * 256 + bj * 128 + wc * 32 + 8 * fq, vc = col - 2048;
                        const f32x4 o0 = acc[ai][bj][m][0] * rs + *(const f32x4*)(shb + col), o1 = acc[ai][bj][m][1] * rs + *(const f32x4*)(shb + col + 4);
                        u32x4 w; w.x = pk2(o0[0], o0[1]); w.y = pk2(o0[2], o0[3]); w.z = pk2(o1[0], o1[1]); w.w = pk2(o1[2], o1[3]);
                        *(u32x4*)(Vb + (size_t)row * DM + vc) = w;
                        float* op = (row < MP ? nvp + (size_t)row * DM : nvs + (size_t)(row - MP) * DM) + vc; __builtin_nontemporal_store(o0, (f32x4*)op); __builtin_nontemporal_store(o1, (f32x4*)(op + 4));
                    }
                }
            }
    }
};

__device__ __forceinline__ int slot_col(int mapid, int s) {
    if (mapid == 1) { const int pn = s >> 8, bj = (s >> 7) & 1, r = s & 127; return FF * bj + 128 * pn + r; }
    if (mapid == 2) { if (s >= 2048) return s; const int pn = s >> 8, bj = (s >> 7) & 1, wc = (s >> 5) & 3, l5 = s & 31; return 256 * pn + 64 * wc + 32 * bj + l5; }
    return s;
}
__device__ __forceinline__ void transpose_item(const float* W, int ldw, int nvalid, int K, int nslots, bf16_t* WT, int mapid, LAS float* scr, int item, int lane) {
    const int nblk = nslots / 32, kb = item / nblk, nb = item % nblk, k0 = 64 * kb, s0 = 32 * nb, c0 = slot_col(mapid, s0);
    const int cc = c0 + (lane & 31); const bool ok = cc < nvalid;
#pragma unroll 8
    for (int i = 0; i < 32; ++i) { const int kk = 2 * i + (lane >> 5); scr[kk * 33 + (lane & 31)] = ok ? W[(size_t)(k0 + kk) * ldw + cc] : 0.f; }
    asm volatile("s_waitcnt lgkmcnt(0)" ::: "memory");
    const int c = lane & 7;
#pragma unroll
    for (int j = 0; j < 4; ++j) { const int n = (lane >> 3) + 8 * j; const LAS float* s = scr + (8 * c) * 33 + n;
        u32x4 o; o.x = pk2(s[0 * 33], s[1 * 33]); o.y = pk2(s[2 * 33], s[3 * 33]); o.z = pk2(s[4 * 33], s[5 * 33]); o.w = pk2(s[6 * 33], s[7 * 33]);
        *(u32x4*)(WT + (size_t)(s0 + n) * K + k0 + 8 * c) = o; }
    asm volatile("s_waitcnt lgkmcnt(0)" ::: "memory");
}

template <class ActF>
__device__ __forceinline__ void sg48_item(const float* W, int ldw, int nvalid, const float* bias, float* out, int ldo, int n0, ActF actf, LAS unsigned char* lds) {
    int tid_ = threadIdx.x; asm volatile("" : "+v"(tid_));
    const int tid = tid_, wave = __builtin_amdgcn_readfirstlane(tid >> 6), lane = tid & 63, r = lane & 31, hh = lane >> 5;
    LAS unsigned char* A = lds;
    LAS float* P = (LAS float*)(lds + 99328);
#pragma unroll 4
    for (int it = 0; it < 24; ++it) {
        const int i = tid + 512 * it, b = i >> 8, k4 = (i & 255) * 4;
        const f32x4 v = actf(b, k4);
        *(LAS u32x2*)(A + b * 2064 + k4 * 2) = (u32x2){pk2(v[0], v[1]), pk2(v[2], v[3])};
    }
    for (int i = tid; i < NB * 64; i += 512) P[i] = 0.f;
    __syncthreads();
    f32x16 acc[2][2];
#pragma unroll
    for (int bb = 0; bb < 2; ++bb)
#pragma unroll
        for (int nb = 0; nb < 2; ++nb)
#pragma unroll
            for (int i = 0; i < 16; ++i) acc[bb][nb][i] = 0.f;
    const int kbase = wave * 128;
    int ncol[2]; bool okc[2];
#pragma unroll
    for (int nb = 0; nb < 2; ++nb) { ncol[nb] = n0 + 32 * nb + r; okc[nb] = ncol[nb] < nvalid; if (!okc[nb]) ncol[nb] = 0; }
    const int brow1 = (32 + r < NB) ? 32 + r : NB - 1;
    float wv[2][2][8];
#pragma unroll
    for (int nb = 0; nb < 2; ++nb)
#pragma unroll
        for (int j = 0; j < 8; ++j) wv[0][nb][j] = W[(size_t)(kbase + 8 * hh + j) * ldw + ncol[nb]];
#pragma unroll
    for (int ks = 0; ks < 8; ++ks) {
        if (ks + 1 < 8) {
#pragma unroll
            for (int nb = 0; nb < 2; ++nb)
#pragma unroll
                for (int j = 0; j < 8; ++j) wv[(ks + 1) & 1][nb][j] = W[(size_t)(kbase + 16 * (ks + 1) + 8 * hh + j) * ldw + ncol[nb]];
        }
        const bf16x8 a0 = *(const LAS bf16x8*)(A + r * 2064 + (kbase + 16 * ks + 8 * hh) * 2), a1 = *(const LAS bf16x8*)(A + brow1 * 2064 + (kbase + 16 * ks + 8 * hh) * 2);
#pragma unroll
        for (int nb = 0; nb < 2; ++nb) {
            u32x4 pw;
#pragma unroll
            for (int j = 0; j < 4; ++j) pw[j] = okc[nb] ? pk2(wv[ks & 1][nb][2 * j], wv[ks & 1][nb][2 * j + 1]) : 0u;
            const bf16x8 bw = __builtin_bit_cast(bf16x8, pw);
            acc[0][nb] = MFMA32(a0, bw, acc[0][nb]); acc[1][nb] = MFMA32(a1, bw, acc[1][nb]);
        }
    }
    for (int w8 = 0; w8 < 8; ++w8) {
        if (wave == w8) {
#pragma unroll
            for (int nb = 0; nb < 2; ++nb) {
#pragma unroll
                for (int i = 0; i < 16; ++i) P[crow(i, hh) * 64 + 32 * nb + r] += acc[0][nb][i];
#pragma unroll
                for (int i = 0; i < 8; ++i) P[(32 + crow(i, hh)) * 64 + 32 * nb + r] += acc[1][nb][i];
            }
        }
        __syncthreads();
    }
    for (int i = tid; i < NB * 64; i += 512) { const int b = i >> 6, nn = n0 + (i & 63); if (nn < nvalid) out[(size_t)b * ldo + nn] = P[i] + (bias ? bias[nn] : 0.f); }
    __syncthreads();
}

constexpr int GL_QE = 0, GL_KE = 17408, GL_KDT = 34816, GL_V = 53248, GL_ATT = 90112, GL_ALOW = 99328, GL_BQ = 103424, GL_DEC = 107520, GL_SSQ = 108032, GL_V1 = 110080, GL_ALOW1 = 146944;
__device__ __forceinline__ bf16x8 pack8(const f32x16& x, int s) {
    u32x4 p; p.x = pk2(x[8 * s], x[8 * s + 1]); p.y = pk2(x[8 * s + 2], x[8 * s + 3]); p.z = pk2(x[8 * s + 4], x[8 * s + 5]); p.w = pk2(x[8 * s + 6], x[8 * s + 7]);
    return __builtin_bit_cast(bf16x8, p);
}
__device__ __forceinline__ s16x4 tr_read(LAS unsigned char* p) { return __builtin_bit_cast(s16x4, __builtin_amdgcn_ds_read_tr16_b64_v4i16((LAS v4i16_t*)p)); }
__device__ __forceinline__ bf16x8 cat8(s16x4 lo, s16x4 hi) { return (bf16x8){lo[0], lo[1], lo[2], lo[3], hi[0], hi[1], hi[2], hi[3]}; }

#define LBAR() asm volatile("s_waitcnt lgkmcnt(0)\n\ts_barrier" ::: "memory")
template <int C>
__device__ __forceinline__ void gla_unit(const bf16_t* QKVR, const float* alow, const float* w_alpha, const float* b_alpha, const float* gnorm, bf16_t* O,
                                         int rowbase, int T, int h, const float* S0, float* Sout, LAS unsigned char* lds) {
    constexpr int NTB = C / 32, NKS = C / 16, NE = C / 8;
    int tid_ = threadIdx.x; asm volatile("" : "+v"(tid_));
    const int tid = tid_, lane = tid & 63, w = __builtin_amdgcn_readfirstlane(tid >> 6), r = lane & 31, hh = lane >> 5;
    const int e_lane = 32 * w + r;
    f32x16 S[4];
#pragma unroll
    for (int db = 0; db < 4; ++db)
#pragma unroll
        for (int i = 0; i < 16; ++i) S[db][i] = S0 ? S0[(size_t)(32 * db + crow(i, hh)) * 256 + e_lane] : 0.f;
    const int d0 = 2 * lane, te = w;
    const unsigned lo_v = (unsigned)((tid >> 5) * 3072 + (tid & 31) * 8), lo_q = (unsigned)d0, lo_r = (unsigned)(r * 3072 + 4 * hh), lo_o = (unsigned)(r * 1024 + 4 * hh), lo_a = (unsigned)((tid < C * 4 ? tid : C * 4 - 1) * 4);
    const bool p1act = (te * 8 < C);
    const float bal0 = b_alpha[h * 128 + d0], bal1 = b_alpha[h * 128 + d0 + 1];
    const int ltb = w >> 2, ldb = w & 3;
    const bool lact = (ltb < NTB);
    bf16x8 wbh;
    {
        float wv[8];
#pragma unroll
        for (int j = 0; j < 8; ++j) wv[j] = w_alpha[(8 * hh + j) * 512 + h * 128 + 32 * ldb + r];
        u32x4 ph;
#pragma unroll
        for (int j = 0; j < 4; ++j) ph[j] = pk2(wv[2 * j], wv[2 * j + 1]);
        wbh = __builtin_bit_cast(bf16x8, ph);
    }
    LAS float* BQ = (LAS float*)(lds + GL_BQ); LAS float* DEC = (LAS float*)(lds + GL_DEC); LAS float* SSQ = (LAS float*)(lds + GL_SSQ);
    LAS unsigned char* LG = lds + GL_QE;
    const int nch = T / C;
    if (tid < C * 4) *(LAS f32x4*)(lds + GL_ALOW + tid * 16) = *(const f32x4*)(alow + (size_t)rowbase * 16 + tid * 4);
    for (int i = tid; i < C * 32; i += 512) { const int s = i >> 5, ch = i & 31; *(LAS u32x4*)(lds + GL_V + s * 576 + ch * 16) = *(const u32x4*)(QKVR + (size_t)(rowbase + s) * 3072 + 1024 + h * 256 + ch * 8); }
    unsigned qreg[8], kreg[8];
    if (p1act) {
#pragma unroll
        for (int i = 0; i < 8; ++i) { const bf16_t* qp = QKVR + (size_t)(rowbase + 8 * te + i) * 3072 + h * 128; qreg[i] = *(const unsigned*)(qp + lo_q); kreg[i] = *(const unsigned*)(qp + 512 + lo_q); }
    }
    for (int ci = 0; ci < nch; ++ci) {
        const int row0 = rowbase + ci * C;
        const bool has_next = ci + 1 < nch;
        LAS unsigned char* Vc = lds + ((ci & 1) ? GL_V1 : GL_V); LAS unsigned char* Ac = lds + ((ci & 1) ? GL_ALOW1 : GL_ALOW);
        LBAR();
        u32x4 vn[C / 16]; f32x4 an;
        if (has_next) {
            const int rn = row0 + C;
#pragma unroll
            for (int k = 0; k < C / 16; ++k) { const bf16_t* vp = QKVR + (size_t)(rn + 16 * k) * 3072 + 1024 + h * 256; vn[k] = *(const u32x4*)(vp + lo_v); }
            { const float* apn = alow + (size_t)rn * 16; an = *(const f32x4*)(apn + lo_a); }
        }
        if (lact) {
            const LAS f32x4* ap = (const LAS f32x4*)(Ac + (32 * ltb + r) * 64 + hh * 32);
            const f32x4 a0 = ap[0], a1 = ap[1];
            u32x4 ph, pl;
            ph[0] = pk2(a0[0], a0[1]); ph[1] = pk2(a0[2], a0[3]); ph[2] = pk2(a1[0], a1[1]); ph[3] = pk2(a1[2], a1[3]);
            pl[0] = pk2(a0[0] - bflo(ph[0]), a0[1] - bfhi(ph[0])); pl[1] = pk2(a0[2] - bflo(ph[1]), a0[3] - bfhi(ph[1]));
            pl[2] = pk2(a1[0] - bflo(ph[2]), a1[1] - bfhi(ph[2])); pl[3] = pk2(a1[2] - bflo(ph[3]), a1[3] - bfhi(ph[3]));
            const bf16x8 ah = __builtin_bit_cast(bf16x8, ph), al = __builtin_bit_cast(bf16x8, pl);
            f32x16 lgv;
#pragma unroll
            for (int i = 0; i < 16; ++i) lgv[i] = 0.f;
            lgv = MFMA32(ah, wbh, lgv); lgv = MFMA32(al, wbh, lgv);
#pragma unroll
            for (int i = 0; i < 16; ++i) *(LAS float*)(LG + (32 * ltb + crow(i, hh)) * 528 + (32 * ldb + r) * 4) = lgv[i];
        }
        LBAR();
        float bl0[8], bl1[8]; float run0 = 0.f, run1 = 0.f;
        if (p1act) {
#pragma unroll
            for (int i = 0; i < 8; ++i) {
                const f32x2_t lv = *(const LAS f32x2_t*)(LG + (8 * te + i) * 528 + d0 * 4);
                const float l0 = lv[0] + bal0, l1 = lv[1] + bal1;
                run0 += (fminf(l0, 0.f) - __logf(1.f + __expf(-fabsf(l0)))) * (1.f / 16.f); bl0[i] = run0;
                run1 += (fminf(l1, 0.f) - __logf(1.f + __expf(-fabsf(l1)))) * (1.f / 16.f); bl1[i] = run1;
            }
            *(LAS f32x2_t*)(BQ + te * 128 + d0) = (f32x2_t){run0, run1};
        }
        if (has_next) {
            LAS unsigned char* Vn = lds + (((ci + 1) & 1) ? GL_V1 : GL_V); LAS unsigned char* An = lds + (((ci + 1) & 1) ? GL_ALOW1 : GL_ALOW);
#pragma unroll
            for (int k = 0; k < C / 16; ++k) { const int i = tid + 512 * k, s = i >> 5, ch = i & 31; *(LAS u32x4*)(Vn + s * 576 + ch * 16) = vn[k]; }
            if (tid < C * 4) *(LAS f32x4*)(An + tid * 16) = an;
        }
        LBAR();
        if (p1act) {
            float off0 = 0.f, off1 = 0.f, tot0 = 0.f, tot1 = 0.f;
#pragma unroll
            for (int q2 = 0; q2 < NE; ++q2) { const f32x2_t v = *(const LAS f32x2_t*)(BQ + q2 * 128 + d0); if (q2 < te) { off0 += v[0]; off1 += v[1]; } tot0 += v[0]; tot1 += v[1]; }
            float kd0[8], kd1[8];
#pragma unroll
            for (int i = 0; i < 8; ++i) {
                const int t = 8 * te + i; const float b0 = bl0[i] + off0, b1 = bl1[i] + off1;
                const float q0 = bflo(qreg[i]), q1 = bfhi(qreg[i]), k0 = bflo(kreg[i]), k1 = bfhi(kreg[i]);
                *(LAS unsigned*)(lds + GL_QE + t * 272 + d0 * 2) = pk2(q0 * GLA_QSC * __expf(b0), q1 * GLA_QSC * __expf(b1));
                *(LAS unsigned*)(lds + GL_KE + t * 272 + d0 * 2) = pk2(k0 * __expf(-b0), k1 * __expf(-b1));
                kd0[i] = k0 * __expf(tot0 - b0); kd1[i] = k1 * __expf(tot1 - b1);
            }
            *(LAS u32x4*)(lds + GL_KDT + d0 * 144 + te * 16) = (u32x4){pk2(kd0[0], kd0[1]), pk2(kd0[2], kd0[3]), pk2(kd0[4], kd0[5]), pk2(kd0[6], kd0[7])};
            *(LAS u32x4*)(lds + GL_KDT + (d0 + 1) * 144 + te * 16) = (u32x4){pk2(kd1[0], kd1[1]), pk2(kd1[2], kd1[3]), pk2(kd1[4], kd1[5]), pk2(kd1[6], kd1[7])};
            if (te == 0) *(LAS f32x2_t*)(DEC + d0) = (f32x2_t){__expf(tot0), __expf(tot1)};
        }
        LBAR();
        if (w < (NTB == 2 ? 3 : 1)) {
            const int sb = (w == 2) ? 1 : 0, tb = (w == 0) ? 0 : 1;
            f32x16 a;
#pragma unroll
            for (int i = 0; i < 16; ++i) a[i] = 0.f;
#pragma unroll
            for (int ks = 0; ks < 8; ++ks) {
                const bf16x8 A = *(const LAS bf16x8*)(lds + GL_KE + (32 * sb + r) * 272 + (16 * ks + 8 * hh) * 2);
                const bf16x8 B = *(const LAS bf16x8*)(lds + GL_QE + (32 * tb + r) * 272 + (16 * ks + 8 * hh) * 2);
                a = MFMA32(A, B, a);
            }
            const int t = 32 * tb + r;
#pragma unroll
            for (int g = 0; g < 4; ++g) {
                const int sbase = 32 * sb + 8 * g + 4 * hh;
                const float v0 = (sbase + 0 <= t) ? a[4 * g + 0] : 0.f, v1 = (sbase + 1 <= t) ? a[4 * g + 1] : 0.f, v2 = (sbase + 2 <= t) ? a[4 * g + 2] : 0.f, v3 = (sbase + 3 <= t) ? a[4 * g + 3] : 0.f;
                *(LAS u32x2*)(lds + GL_ATT + t * 144 + sbase * 2) = (u32x2){pk2(v0, v1), pk2(v2, v3)};
            }
        }
        f32x16 o[NTB];
#pragma unroll
        for (int tb = 0; tb < NTB; ++tb)
#pragma unroll
            for (int i = 0; i < 16; ++i) o[tb][i] = 0.f;
#pragma unroll
        for (int db = 0; db < 4; ++db)
#pragma unroll
            for (int s2 = 0; s2 < 2; ++s2) {
                const bf16x8 A = pack8(S[db], s2);
#pragma unroll
                for (int tb = 0; tb < NTB; ++tb) {
                    LAS unsigned char* qb = lds + GL_QE + (32 * tb + r) * 272 + (32 * db + 16 * s2 + 4 * hh) * 2;
                    const s16x4 lo = *(const LAS s16x4*)qb, hi = *(const LAS s16x4*)(qb + 16);
                    o[tb] = MFMA32(A, cat8(lo, hi), o[tb]);
                }
                __builtin_amdgcn_sched_barrier(0);
            }
        LBAR();
        u32x2 rg[NTB][4];
#pragma unroll
        for (int tb = 0; tb < NTB; ++tb)
#pragma unroll
            for (int g = 0; g < 4; ++g) { const bf16_t* rp = QKVR + (size_t)(row0 + 32 * tb) * 3072 + 2048 + h * 256 + 32 * w + 8 * g; rg[tb][g] = *(const u32x2*)(rp + lo_r); }
        bf16x8 vf[NKS];
#pragma unroll
        for (int ks = 0; ks < NKS; ++ks) {
            LAS unsigned char* vb = Vc + (16 * ks + 8 * hh + ((lane & 15) >> 2)) * 576 + (32 * w + 16 * ((lane >> 4) & 1) + 4 * (lane & 3)) * 2;
            vf[ks] = cat8(tr_read(vb), tr_read(vb + 4 * 576));
        }
#pragma unroll
        for (int tb = 0; tb < NTB; ++tb)
#pragma unroll
            for (int ks = 0; ks < NKS; ++ks) {
                if (tb == 0 && ks >= 2) continue;
                const bf16x8 B = *(const LAS bf16x8*)(lds + GL_ATT + (32 * tb + r) * 144 + (16 * ks + 8 * hh) * 2);
                o[tb] = MFMA32(vf[ks], B, o[tb]);
            }
#pragma unroll
        for (int db = 0; db < 4; ++db) {
#pragma unroll
            for (int g = 0; g < 4; ++g) { const f32x4 dc = *(const LAS f32x4*)(DEC + 32 * db + 8 * g + 4 * hh);
                S[db][4 * g] *= dc[0]; S[db][4 * g + 1] *= dc[1]; S[db][4 * g + 2] *= dc[2]; S[db][4 * g + 3] *= dc[3]; }
#pragma unroll
            for (int ks = 0; ks < NKS; ++ks) {
                const bf16x8 A = *(const LAS bf16x8*)(lds + GL_KDT + (32 * db + r) * 144 + (16 * ks + 8 * hh) * 2);
                S[db] = MFMA32(A, vf[ks], S[db]);
            }
            __builtin_amdgcn_sched_barrier(0);
        }
#pragma unroll
        for (int tb = 0; tb < NTB; ++tb) {
            float q = 0.f;
#pragma unroll
            for (int i = 0; i < 16; ++i) q += o[tb][i] * o[tb][i];
            q += __shfl_xor(q, 32);
            if (hh == 0) SSQ[w * 64 + 32 * tb + r] = q;
        }
        LBAR();
        if (has_next) {
            const int rn = row0 + C;
            int l2_ = threadIdx.x; asm volatile("" : "+v"(l2_)); const unsigned lo_q2 = 2u * (unsigned)(l2_ & 63);
            if (p1act) {
#pragma unroll
                for (int i = 0; i < 8; ++i) { const bf16_t* qp = QKVR + (size_t)(rn + 8 * te + i) * 3072 + h * 128; qreg[i] = *(const unsigned*)(qp + lo_q2); kreg[i] = *(const unsigned*)(qp + 512 + lo_q2); }
            }
        }
#pragma unroll
        for (int tb = 0; tb < NTB; ++tb) {
            const int t = 32 * tb + r;
            float tot = 0.f;
#pragma unroll
            for (int w2 = 0; w2 < 8; ++w2) tot += SSQ[w2 * 64 + t];
            const float rs = rsqrtf(tot * (1.f / 256.f) + EPS);
#pragma unroll
            for (int g = 0; g < 4; ++g) {
                const int e0 = 32 * w + 8 * g + 4 * hh;
                const f32x4 gnv = *(const f32x4*)(gnorm + 32 * w + 8 * g + (unsigned)(4 * hh));
                const u32x2 rr = rg[tb][g];
                const float y0 = o[tb][4 * g] * rs * gnv[0] * silu_f(bflo(rr.x)), y1 = o[tb][4 * g + 1] * rs * gnv[1] * silu_f(bfhi(rr.x));
                const float y2 = o[tb][4 * g + 2] * rs * gnv[2] * silu_f(bflo(rr.y)), y3 = o[tb][4 * g + 3] * rs * gnv[3] * silu_f(bfhi(rr.y));
                { bf16_t* op = O + (size_t)(row0 + 32 * tb) * DM + h * 256 + 32 * w + 8 * g; *(u32x2*)(op + lo_o) = (u32x2){pk2(y0, y1), pk2(y2, y3)}; }
            }
        }
    }
    {
        int t2 = threadIdx.x; asm volatile("" : "+v"(t2));
        const unsigned lo_s = (unsigned)(4 * ((t2 & 63) >> 5) * 256 + 32 * (t2 >> 6) + (t2 & 31));
#pragma unroll
        for (int db = 0; db < 4; ++db)
#pragma unroll
            for (int i = 0; i < 16; ++i) { float* sp = Sout + (size_t)(32 * db + (i & 3) + 8 * (i >> 2)) * 256; sp[lo_s] = S[db][i]; }
    }
    __syncthreads();
}

constexpr int AT_X = 36864;
struct AttnSrc { const bf16_t* Qb; const bf16_t* Kb; const bf16_t* Vb; const bf16_t* KC; const bf16_t* VC; bf16_t* O; const float* dnorm; };

__device__ __forceinline__ void attn_unit(const AttnSrc& A, int grp, int b, int h, int qb, float lam, LAS unsigned char* lds) {
    int tid_ = threadIdx.x; asm volatile("" : "+v"(tid_));
    const int tid = tid_, lane = tid & 63, w = __builtin_amdgcn_readfirstlane(tid >> 6), r = lane & 31, hh = lane >> 5;
    const int c = w & 1, rb = w >> 1;
    const int rowbase = grp == 0 ? b * 2048 : MP + b * 32;
    const int p0 = grp == 0 ? 128 * qb : 0;
    const int NT = grp == 0 ? 2 * qb + 2 : 33;
    const bool active = grp == 0 ? true : (rb == 0);
    const int my_last = grp == 0 ? 2 * qb + (rb >> 1) : 32;
    bf16x8 qf[4];
    {
        const bf16_t* Qw = A.Qb + (size_t)(rowbase + p0 + (active ? 32 * rb : 0) + r) * DM + h * 128 + c * 64 + 8 * hh;
#pragma unroll
        for (int ks = 0; ks < 4; ++ks) qf[ks] = *(const bf16x8*)(Qw + 16 * ks);
    }
    f32x16 Oa[4];
#pragma unroll
    for (int d = 0; d < 4; ++d)
#pragma unroll
        for (int i = 0; i < 16; ++i) Oa[d][i] = 0.f;
    float m_run = 0.f, lsum = 0.f;
    u32x4 kreg[2], vreg[2];
#define LOAD_TILE(t_) do { _Pragma("unroll") for (int i_ = 0; i_ < 2; ++i_) { \
            const int id_ = tid + 512 * i_, row_ = id_ >> 4, ch_ = id_ & 15, key_ = 64 * (t_) + row_; \
            const bf16_t* kp_; const bf16_t* vp_; bool ok_ = true; \
            if (grp == 0) { const size_t o_ = (size_t)(rowbase + key_) * DM + h * 128 + ch_ * 8; kp_ = A.Kb + o_; vp_ = A.Vb + o_; } \
            else if (key_ < 2048) { const size_t o_ = (size_t)(b * 2048 + key_) * DM + h * 128 + ch_ * 8; kp_ = A.KC + o_; vp_ = A.VC + o_; } \
            else { ok_ = key_ < 2080; const size_t o_ = (size_t)(rowbase + (ok_ ? key_ - 2048 : 0)) * DM + h * 128 + ch_ * 8; kp_ = A.Kb + o_; vp_ = A.Vb + o_; } \
            kreg[i_] = *(const u32x4*)kp_; vreg[i_] = *(const u32x4*)vp_; \
            if (!ok_) { kreg[i_] = (u32x4){0u, 0u, 0u, 0u}; vreg[i_] = (u32x4){0u, 0u, 0u, 0u}; } } } while (0)
    LOAD_TILE(0);
    const bool grpB = (w >= 4);
    bf16x8 pw[4];
#define QK_SOFTMAX(t_) do { \
        LAS unsigned char* Kt = lds + ((t_) % 3) * 32768; \
        f32x16 s0, s1; \
        _Pragma("unroll") for (int i = 0; i < 16; ++i) { s0[i] = 0.f; s1[i] = 0.f; } \
        _Pragma("unroll") for (int ks = 0; ks < 4; ++ks) { \
            const int chx = ((8 * c + 2 * ks + hh) ^ (r & 15)) * 16; \
            const bf16x8 a0 = *(const LAS bf16x8*)(Kt + r * 256 + chx), a1 = *(const LAS bf16x8*)(Kt + (32 + r) * 256 + chx); \
            s0 = MFMA32(a0, qf[ks], s0); s1 = MFMA32(a1, qf[ks], s1); } \
        if (grp == 1 && (t_) == 32) { _Pragma("unroll") for (int i = 0; i < 16; ++i) s1[i] = -1e30f; } \
          \
          \
        float ps = 0.f; \
        _Pragma("unroll") for (int i = 0; i < 16; ++i) { s0[i] = __builtin_amdgcn_exp2f(s0[i]); s1[i] = __builtin_amdgcn_exp2f(s1[i]); ps += s0[i] + s1[i]; } \
        lsum += ps; \
        pw[0] = pack8(s0, 0); pw[1] = pack8(s0, 1); pw[2] = pack8(s1, 0); pw[3] = pack8(s1, 1); \
    } while (0)
#define PV_STEP(t_) do { \
        LAS unsigned char* Vt = lds + ((t_) % 3) * 32768 + 16384; \
        const int i4 = (lane >> 2) & 3, p = lane & 3, g16 = (lane >> 4) & 1; \
        _Pragma("unroll") for (int bs = 0; bs < 4; ++bs) { \
            const int k0 = 16 * bs + 4 * hh; \
            _Pragma("unroll") for (int d = 0; d < 4; ++d) { \
                const int chv = ((4 * d + 2 * g16 + (p >> 1)) ^ (4 * i4)) * 16 + 8 * (p & 1); \
                const s16x4 lo = tr_read(Vt + (k0 + i4) * 256 + chv), hi = tr_read(Vt + (k0 + 8 + i4) * 256 + chv); \
                Oa[d] = MFMA32(cat8(lo, hi), pw[bs], Oa[d]); } } \
    } while (0)
#define SAMPLE_STEP(t_, S2_) do { \
        LAS unsigned char* Kt = lds + ((t_) % 3) * 32768; LAS unsigned char* Vt = Kt + 16384; \
        f32x16 sv; \
        _Pragma("unroll") for (int i = 0; i < 16; ++i) sv[i] = 0.f; \
        _Pragma("unroll") for (int ks = 0; ks < 4; ++ks) { \
            const int chx = ((8 * c + 2 * ks + hh) ^ (r & 15)) * 16; \
            const bf16x8 a0 = *(const LAS bf16x8*)(Kt + (32 * sblk + r) * 256 + chx); \
            sv = MFMA32(a0, qf[ks], sv); } \
        float ps = 0.f; \
        _Pragma("unroll") for (int j = 0; j < 8; ++j) { sv[8 * (S2_) + j] = __builtin_amdgcn_exp2f(sv[8 * (S2_) + j]); ps += sv[8 * (S2_) + j]; } \
        lsum += ps; \
        const bf16x8 pwv = pack8(sv, (S2_)); \
        const int i4 = (lane >> 2) & 3, p = lane & 3, g16 = (lane >> 4) & 1; \
        const int k0 = 16 * (2 * sblk + (S2_)) + 4 * hh; \
        _Pragma("unroll") for (int d = 0; d < 4; ++d) { \
            const int chv = ((4 * d + 2 * g16 + (p >> 1)) ^ (4 * i4)) * 16 + 8 * (p & 1); \
            const s16x4 lo = tr_read(Vt + (k0 + i4) * 256 + chv), hi = tr_read(Vt + (k0 + 8 + i4) * 256 + chv); \
            Oa[d] = MFMA32(cat8(lo, hi), pwv, Oa[d]); } \
    } while (0)
    if (grp == 1) {
        const int sblk = rb >> 1;
        for (int t = 0; t < NT; ++t) {
            LAS unsigned char* Kt = lds + (t % 3) * 32768; LAS unsigned char* Vt = Kt + 16384;
#pragma unroll
            for (int i = 0; i < 2; ++i) {
                const int id = tid + 512 * i, row = id >> 4, ch = id & 15;
                *(LAS u32x4*)(Kt + row * 256 + ((ch ^ (row & 15)) * 16)) = kreg[i];
                *(LAS u32x4*)(Vt + row * 256 + ((ch ^ (4 * (row & 3))) * 16)) = vreg[i];
            }
            __syncthreads();
            if (t + 1 < NT) LOAD_TILE(t + 1);
            if (!(t == 32 && sblk == 1)) { if (rb & 1) SAMPLE_STEP(t, 1); else SAMPLE_STEP(t, 0); }
        }
        __syncthreads();
        {
            const float lw = lsum + __shfl_xor(lsum, 32);
            LAS float* Pw = (LAS float*)(lds + w * 16384);
#pragma unroll
            for (int d = 0; d < 4; ++d)
#pragma unroll
                for (int i = 0; i < 16; ++i) Pw[(d * 16 + i) * 64 + lane] = Oa[d][i];
            ((LAS float*)(lds + 131072 + w * 256))[lane] = lw;
            __syncthreads();
            if (rb == 0) {
                float lt = lw;
#pragma unroll
                for (int rb2 = 1; rb2 < 4; ++rb2) {
                    const LAS float* P2 = (const LAS float*)(lds + (2 * rb2 + c) * 16384);
#pragma unroll
                    for (int d = 0; d < 4; ++d)
#pragma unroll
                        for (int i = 0; i < 16; ++i) Oa[d][i] += P2[(d * 16 + i) * 64 + lane];
                    lt += ((const LAS float*)(lds + 131072 + (2 * rb2 + c) * 256))[lane];
                }
                lsum = 0.5f * lt;
            }
        }
    } else {
    for (int t = 0; t <= NT; ++t) {
        if (t < NT) {
            LAS unsigned char* Kt = lds + (t % 3) * 32768; LAS unsigned char* Vt = Kt + 16384;
#pragma unroll
            for (int i = 0; i < 2; ++i) {
                const int id = tid + 512 * i, row = id >> 4, ch = id & 15;
                *(LAS u32x4*)(Kt + row * 256 + ((ch ^ (row & 15)) * 16)) = kreg[i];
                *(LAS u32x4*)(Vt + row * 256 + ((ch ^ (4 * (row & 3))) * 16)) = vreg[i];
            }
        }
        __syncthreads();
        if (t + 1 < NT) LOAD_TILE(t + 1);
        const bool doqk = active && t < NT && t <= my_last;
        if (active && grpB && t >= 1 && t - 1 <= my_last) PV_STEP(t - 1);
        if (doqk) QK_SOFTMAX(t);
        if (doqk && !grpB) PV_STEP(t);
    }
    }
    __syncthreads();
    lsum += __shfl_xor(lsum, 32);
    const float inv = active ? 1.f / lsum : 0.f;
    LAS float* X = (LAS float*)(lds + AT_X + rb * 16384);
    if (active && c == 1) {
#pragma unroll
        for (int d = 0; d < 4; ++d)
#pragma unroll
            for (int i = 0; i < 16; ++i) X[(d * 16 + i) * 64 + lane] = Oa[d][i] * inv;
    }
    __syncthreads();
    if (active && c == 0) {
        float q = 0.f;
#pragma unroll
        for (int d = 0; d < 4; ++d)
#pragma unroll
            for (int i = 0; i < 16; ++i) { const float v = Oa[d][i] * inv - lam * X[(d * 16 + i) * 64 + lane]; Oa[d][i] = v; q += v * v; }
        q += __shfl_xor(q, 32);
        const float rs = rsqrtf(q * (1.f / 128.f) + EPS) * (1.f - LAM_INIT1);
        LAS unsigned char* OT = lds + rb * 8704;
#pragma unroll
        for (int d = 0; d < 4; ++d)
#pragma unroll
            for (int g = 0; g < 4; ++g) {
                const int dv = 32 * d + 8 * g + 4 * hh; const f32x4 gnv = *(const f32x4*)(A.dnorm + dv);
                *(LAS u32x2*)(OT + r * 272 + dv * 2) = (u32x2){pk2(Oa[d][4 * g] * rs * gnv[0], Oa[d][4 * g + 1] * rs * gnv[1]), pk2(Oa[d][4 * g + 2] * rs * gnv[2], Oa[d][4 * g + 3] * rs * gnv[3])};
            }
        asm volatile("s_waitcnt lgkmcnt(0)" ::: "memory");
#pragma unroll
        for (int k = 0; k < 8; ++k) {
            const int id = lane + 64 * k, row = id >> 4, ch = id & 15;
            const u32x4 v = *(const LAS u32x4*)(OT + row * 272 + ch * 16);
            *(u32x4*)(A.O + (size_t)(rowbase + p0 + 32 * rb + row) * DM + h * 128 + ch * 8) = v;
        }
    }
    __syncthreads();
}

#ifndef REP_P0
#define REP_P0 1
#endif
#ifndef REP_P2
#define REP_P2 1
#endif
#ifndef REP_G
#define REP_G 1
#endif
#ifndef REP_U
#define REP_U 1
#endif
#ifndef REP_A
#define REP_A 1
#endif
struct Args { const float* in[27]; float* out; unsigned char* ws; };
enum { I_XP = 0, I_XS, I_SGLA, I_CK, I_CV, I_SCONV, I_CP, I_CS, I_NMIX, I_NFFN, I_WADA, I_BADA, I_GWIN, I_GWAL, I_GBAL, I_GNORM, I_GWOUT, I_DWIN, I_DQN, I_DKN, I_DLAM, I_DNORM, I_DWOUT, I_FWIN, I_FCW, I_FCB, I_FWOUT };

#define XB_TMO      128
#define XB_XCNT(j)  (256  + 64 * (j))
#define XB_XSUB(j)  (1280 + 64 * (j))
#define XB_XGEN(j)  (2304 + 64 * (j))
#define XB_TOP      3328
#define XB_TOPGEN   3392
#define XCD_BAR_WORDS 3456
#define XB_SPIN_CAP (1u << 18)

__device__ __forceinline__ unsigned xb_ld(unsigned* p)              { return __hip_atomic_load(p, __ATOMIC_RELAXED, __HIP_MEMORY_SCOPE_AGENT); }
__device__ __forceinline__ unsigned xb_add(unsigned* p, unsigned v) { return __hip_atomic_fetch_add(p, v, __ATOMIC_RELAXED, __HIP_MEMORY_SCOPE_AGENT); }
__device__ __forceinline__ unsigned xb_xcc_id() { return (unsigned)__builtin_amdgcn_s_getreg((3 << 11) | 20) & 0xFu; }
#define XB_SPIN(cond, bar) do { unsigned _sp = 0; while (cond) { __builtin_amdgcn_s_sleep(1); \
    if ((++_sp & 255u) == 0u) { if (xb_ld(&(bar)[XB_TMO])) break; if (_sp > XB_SPIN_CAP) { atomicAdd(&(bar)[XB_TMO], 1u); break; } } } } while (0)

struct XcdBarrier {
    unsigned* bar; unsigned x;
    volatile LAS unsigned* st;
};

__device__ __forceinline__ XcdBarrier xcd_barrier_post(unsigned* bar, volatile LAS unsigned* st) {
    XcdBarrier b; b.bar = bar; b.x = xb_xcc_id(); b.st = st;
    if (threadIdx.x == 0) (void)xb_add(&bar[XB_XCNT(b.x)], 1u);
    return b;
}
__device__ __forceinline__ void xcd_barrier_complete(unsigned* bar, unsigned x, unsigned& nloc, unsigned& nx) {
    const unsigned G = gridDim.x * gridDim.y * gridDim.z;
    unsigned sum, cnt, mine, sp = 0u;
    for (;;) {
        sum = 0u; cnt = 0u; mine = 0u;
#pragma unroll
        for (unsigned j = 0; j < 16; ++j) { const unsigned c = xb_ld(&bar[XB_XCNT(j)]); sum += c; cnt += (c > 0u) ? 1u : 0u; mine = (j == x) ? c : mine; }
        if (sum == G) break;
        __builtin_amdgcn_s_sleep(1);
        if ((++sp & 255u) == 0u) { if (xb_ld(&bar[XB_TMO])) break; if (sp > XB_SPIN_CAP) { atomicAdd(&bar[XB_TMO], 1u); break; } }
    }
    nloc = mine > 0u ? mine : 1u; nx = cnt > 0u ? cnt : 1u;
}

__device__ __forceinline__ void xcd_barrier(const XcdBarrier& b) {
    asm volatile("s_waitcnt vmcnt(0)" ::: "memory");
    __syncthreads();
    if (threadIdx.x == 0) {
        unsigned* bar = b.bar;
        __builtin_amdgcn_s_waitcnt(0);
        unsigned nloc = b.st[0], nx = b.st[1];
        if (nloc == 0u) { xcd_barrier_complete(bar, b.x, nloc, nx); b.st[0] = nloc; b.st[1] = nx; }
        const unsigned old = xb_add(&bar[XB_XSUB(b.x)], 1u);
        const unsigned gen = old / nloc;
        if (old + 1u == (gen + 1u) * nloc) {
            __builtin_amdgcn_fence(__ATOMIC_RELEASE, "agent");
            asm volatile("s_waitcnt vmcnt(0)" ::: "memory");
            const unsigned og = xb_add(&bar[XB_TOP], 1u);
            const unsigned tg = og / nx;
            if (og + 1u == (tg + 1u) * nx) xb_add(&bar[XB_TOPGEN], 1u);
            else XB_SPIN(xb_ld(&bar[XB_TOPGEN]) == tg, bar);
            __builtin_amdgcn_fence(__ATOMIC_ACQUIRE, "agent");
            xb_add(&bar[XB_XGEN(b.x)], 1u);
            asm volatile("s_waitcnt vmcnt(0)" ::: "memory");
        } else {
            XB_SPIN(xb_ld(&bar[XB_XGEN(b.x)]) == gen, bar);
            __builtin_amdgcn_fence(__ATOMIC_ACQUIRE, "agent");
            asm volatile("s_waitcnt vmcnt(0)" ::: "memory");
        }
    }
    __syncthreads();
}

__device__ __forceinline__ unsigned long long ldp(LAS unsigned long long* PT, int i) {
    const unsigned long long v = PT[i];
    const unsigned lo = __builtin_amdgcn_readfirstlane((unsigned)v), hi = __builtin_amdgcn_readfirstlane((unsigned)(v >> 32));
    return ((unsigned long long)hi << 32) | lo;
}
__device__ __forceinline__ void ffn_fixup(const pg8::StaticOrder& S, bf16_t* ACT, const float* Hfirst, const float* Hlast, const float* cw, const float* cb) {
    pg8::Unit u; int lastpm = -1;
    int t_ = threadIdx.x; asm volatile("" : "+v"(t_));
    for (int i = 0; S.next(i, u); ++i) {
        const int pm = u.pm; if (pm >= 256 || pm == lastpm) continue; lastpm = pm;
        const bool first = (pm & 7) == 0;
        const float* hl = Hlast + (size_t)((first ? pm : pm - 1) * 2) * FF2;
        const float* hf = Hfirst + (size_t)(pm * 2) * FF2;
        bf16_t* ab = ACT + (size_t)(pm * 256) * FF;
        for (unsigned f = (unsigned)t_; f < (unsigned)FF; f += 512u) {
            float yu[2], yg[2];
#pragma unroll
            for (int ug = 0; ug < 2; ++ug) {
                const unsigned col = (unsigned)(ug * FF) + f;
                const float P6 = first ? 0.f : hl[col], P7 = first ? 0.f : hl[FF2 + col];
                const float F0 = hf[col], F1 = hf[FF2 + col];
                const float w0 = cw[col], w1 = cw[FF2 + col], w2 = cw[2 * FF2 + col], bb = cb[col];
                const float y0 = bb + w0 * P6 + w1 * P7 + w2 * F0, y1 = bb + w0 * P7 + w1 * F0 + w2 * F1;
                if (ug == 0) { yu[0] = y0; yu[1] = y1; } else { yg[0] = y0; yg[1] = y1; }
            }
            ab[f] = f2bf(silu_f(yg[0]) * yu[0]);
            ab[FF + f] = f2bf(silu_f(yg[1]) * yu[1]);
        }
    }
    asm volatile("s_waitcnt vmcnt(0)" ::: "memory");
    __syncthreads();
}

__global__ void __launch_bounds__(512, 2) fwd(Args a) {
    extern __shared__ __attribute__((aligned(16))) unsigned char lds_[];
    LAS unsigned char* lds = (LAS unsigned char*)lds_;
    cg::grid_group grid = cg::this_grid();
    const int tid = threadIdx.x, lane = tid & 63, wave = __builtin_amdgcn_readfirstlane(tid >> 6);
    const int G = gridDim.x, bx = blockIdx.x;
    const int gw = bx * 8 + wave, NGW = G * 8;
    LAS unsigned long long* PT = (LAS unsigned long long*)(lds + PT_OFF);
    if (tid == 0) {
#pragma unroll
        for (int i = 0; i < 27; ++i) PT[i] = (unsigned long long)a.in[i];
        PT[27] = (unsigned long long)a.out; PT[28] = (unsigned long long)a.ws; PT[29] = (unsigned long long)(a.ws + WS_BAR);
        ((LAS unsigned*)(lds + PT_OFF + 240))[0] = 0u; ((LAS unsigned*)(lds + PT_OFF + 240))[1] = 0u;
    }
    __syncthreads();
    volatile LAS unsigned* xst = (volatile LAS unsigned*)(lds + PT_OFF + 240);
    (void)xcd_barrier_post((unsigned*)(a.ws + WS_BAR), xst);
#define GRID_SYNC() do { XcdBarrier b_; b_.bar = (unsigned*)ldp(PT, 29); b_.x = xb_xcc_id(); b_.st = xst; xcd_barrier(b_); } while (0)
#define GAS __attribute__((address_space(1)))
#define IN(i) ((const float*)(GAS const float*)ldp(PT, (i)))
#define OUTP ((float*)(GAS float*)ldp(PT, 27))
#define WSP(T, off) ((T*)(GAS T*)((GAS unsigned char*)ldp(PT, 28) + (off)))
#define mod WSP(float, WS_MOD)
#define shW WSP(float, WS_SHW)
#define ssq0 WSP(float, WS_SSQ)
#define ssq1 (WSP(float, WS_SSQ) + MTOT)
#define ssq2 (WSP(float, WS_SSQ) + 2 * MTOT)
#define ssq3 (WSP(float, WS_SSQ) + 3 * MTOT)
#define alow WSP(float, WS_ALOW)
#define Hf WSP(float, WS_HF)
#define Hl WSP(float, WS_HL)
#define Wgi WSP(bf16_t, WS_WGI)
#define Wgo WSP(bf16_t, WS_WGO)
#define Wdi WSP(bf16_t, WS_WDI)
#define Wdo WSP(bf16_t, WS_WDO)
#define WU(l) WSP(bf16_t, (l) == 0 ? WS_WU0 : WS_WU1)
#define WD(l) WSP(bf16_t, (l) == 0 ? WS_WD0 : WS_WD1)
#define XM WSP(bf16_t, WS_XM)
#define OB WSP(bf16_t, WS_O)
#define QKVR WSP(bf16_t, WS_QKVR)
#define ACT WSP(bf16_t, WS_QKVR)
#define KC WSP(bf16_t, WS_KC)
#define VC WSP(bf16_t, WS_VC)
#define out OUTP
#define mod0 mod
#define mod1 (mod + (size_t)NB * MODW)

    for (int rep_ = 0; rep_ < REP_P0; ++rep_)
    {
        for (int i = bx * 512 + tid; i < 3 * MTOT; i += G * 512) ssq1[i] = 0.f;
        LAS float* scr = (LAS float*)(lds + wave * 16384);
        for (int it = gw; it < 16 * 104; it += NGW) transpose_item(IN(I_GWIN), GIN, GIN, 1024, GIN_PAD, Wgi, 0, scr, it, lane);
        __syncthreads();
        const float* cp = IN(I_CP); const float* cs = IN(I_CS);
        for (int it = bx; it < 2 * 96; it += G) {
            const int layer = it / 96, cb = it % 96;
            sg48_item(IN(I_WADA) + (size_t)layer * 1024 * MODW, MODW, MODW, IN(I_BADA) + layer * MODW, mod + (size_t)layer * NB * MODW, MODW, 64 * cb,
                      [&](int b, int k) { const f32x4 c = *(const f32x4*)(b < 32 ? cp + b * 1024 + k : cs + (b - 32) * 1024 + k); return (f32x4){silu_f(c[0]), silu_f(c[1]), silu_f(c[2]), silu_f(c[3])}; }, lds);
        }
    }
    grid.sync();
    for (int rep_ = 0; rep_ < REP_P0; ++rep_)
    {
        for (int it = bx; it < 49; it += G) { const float* sh = mod; sg48_item(IN(I_GWIN), GIN, GIN, nullptr, shW + SHW_GLA, GIN_PAD, 64 * it, [&](int b, int k) { return *(const f32x4*)(sh + (size_t)b * MODW + k); }, lds); }
        const float* gain = IN(I_NMIX); const float* xp_ = IN(I_XP); const float* xs_ = IN(I_XS); const float* mod_ = mod; bf16_t* xm_ = XM; float* ssq0_ = ssq0;
        for (int row0_ = gw; row0_ < MTOT; row0_ += 2 * NGW) {
            f32x4 v[2][4]; const float* scp[2];
#pragma unroll
            for (int q = 0; q < 2; ++q) {
                const int row = (row0_ + q * NGW < MTOT) ? row0_ + q * NGW : row0_;
                const float* xr = row < MP ? xp_ + (size_t)row * DM : xs_ + (size_t)(row - MP) * DM;
                scp[q] = mod_ + (size_t)bidx_of(row) * MODW + 1024;
#pragma unroll
                for (int j = 0; j < 4; ++j) v[q][j] = __builtin_nontemporal_load((const f32x4*)(xr + 4 * lane + 256 * j));
            }
#pragma unroll
            for (int q = 0; q < 2; ++q) {
                const int row = row0_ + q * NGW;
                if (row < MTOT) {
                    float s1 = 0.f;
#pragma unroll
                    for (int j = 0; j < 4; ++j) s1 += (v[q][j][0] * v[q][j][0] + v[q][j][1] * v[q][j][1]) + (v[q][j][2] * v[q][j][2] + v[q][j][3] * v[q][j][3]);
                    s1 = wave_sum(s1);
                    if (lane == 0) ssq0_[row] = s1;
#pragma unroll
                    for (int j = 0; j < 4; ++j) { const int col = 4 * lane + 256 * j; const f32x4 s = *(const f32x4*)(gain + col) * (*(const f32x4*)(scp[q] + col) + 1.f); const f32x4 z = v[q][j] * s;
                        *(u32x2*)(xm_ + (size_t)row * DM + col) = (u32x2){pk2(z[0], z[1]), pk2(z[2], z[3])}; }
                }
            }
        }
    }
    GRID_SYNC();
    for (int rep_ = 0; rep_ < REP_G; ++rep_)
    {
        pg8::Gemm g{XM, Wgi, MTOT, GIN_PAD, 1024}; pg8::StaticOrder S; S.init(MTOT, GIN_PAD, G, bx);
        EpiGlaIn E{QKVR, alow, ssq0, shW + SHW_GLA};
        pg8::gemm_phase<EpiGlaIn, pg8::StaticOrder, true, true, false>(lds, g, S, E, lds + XL_OFF);
    }
    GRID_SYNC();
    for (int rep_ = 0; rep_ < REP_P2; ++rep_)
    {
        if (bx < 128) { const int b = bx >> 2, h = bx & 3;
            gla_unit<64>(QKVR, alow, IN(I_GWAL), IN(I_GBAL), IN(I_GNORM), OB, b * 2048, 2048, h, nullptr, out + O_GSP + (size_t)(b * 4 + h) * 128 * 256, lds);
        } else if (bx < 192) { const int b = (bx - 128) >> 2, h = bx & 3;
            gla_unit<32>(QKVR, alow, IN(I_GWAL), IN(I_GBAL), IN(I_GNORM), OB, MP + b * 32, 32, h, IN(I_SGLA) + (size_t)(b * 4 + h) * 128 * 256, out + O_GSS + (size_t)(b * 4 + h) * 128 * 256, lds);
        }
        if (bx >= 128) {
            const int aw = bx - 128, NAW = G - 128;
            LAS float* scr = (LAS float*)(lds + wave * 16384);
            constexpr int I1 = 16 * 32, I2 = 16 * 96, I3 = 16 * 32, I4 = 16 * 176, I5 = 44 * 32;
            constexpr int NIT = I1 + I2 + I3 + 2 * I4 + 2 * I5;
            for (int it = aw * 8 + wave; it < NIT; it += NAW * 8) {
                int r = it;
                if (r < I1) { transpose_item(IN(I_GWOUT), 1024, 1024, 1024, 1024, Wgo, 0, scr, r, lane); continue; } r -= I1;
                if (r < I2) { transpose_item(IN(I_DWIN), DIN, DIN, 1024, DIN, Wdi, 2, scr, r, lane); continue; } r -= I2;
                if (r < I3) { transpose_item(IN(I_DWOUT), 1024, 1024, 1024, 1024, Wdo, 0, scr, r, lane); continue; } r -= I3;
                if (r < I4) { transpose_item(IN(I_FWIN), FF2, FF2, 1024, FF2, WU(0), 1, scr, r, lane); continue; } r -= I4;
                if (r < I4) { transpose_item(IN(I_FWIN) + (size_t)1024 * FF2, FF2, FF2, 1024, FF2, WU(1), 1, scr, r, lane); continue; } r -= I4;
                if (r < I5) { transpose_item(IN(I_FWOUT), 1024, 1024, FF, 1024, WD(0), 0, scr, r, lane); continue; } r -= I5;
                transpose_item(IN(I_FWOUT) + (size_t)FF * 1024, 1024, 1024, FF, 1024, WD(1), 0, scr, r, lane);
            }
            __syncthreads();
            for (int it = aw; it < 88 + 48 + 88; it += NAW) {
                int r = it;
                if (r < 88) { const float* sh = mod + 3072; sg48_item(IN(I_FWIN), FF2, FF2, nullptr, shW + SHW_UP0, FF2, 64 * r, [&](int b, int k) { return *(const f32x4*)(sh + (size_t)b * MODW + k); }, lds); continue; } r -= 88;
                if (r < 48) { const float* sh = mod + (size_t)NB * MODW; sg48_item(IN(I_DWIN), DIN, DIN, nullptr, shW + SHW_DIF, DIN, 64 * r, [&](int b, int k) { return *(const f32x4*)(sh + (size_t)b * MODW + k); }, lds); continue; } r -= 48;
                { const float* sh = mod + (size_t)NB * MODW + 3072; sg48_item(IN(I_FWIN) + (size_t)1024 * FF2, FF2, FF2, nullptr, shW + SHW_UP1, FF2, 64 * r, [&](int b, int k) { return *(const f32x4*)(sh + (size_t)b * MODW + k); }, lds); }
            }
            const size_t NCH = (size_t)16 * 2048 * 1024 / 8;
            for (int kv = 0; kv < 2; ++kv) {
                const float* srcb = kv ? IN(I_CV) : IN(I_CK); bf16_t* dstb = kv ? VC : KC;
                const size_t step = (size_t)NAW * 512;
                for (size_t i = (size_t)aw * 512 + tid; i < NCH; i += 4 * step) {
                    f32x4 x0[4], x1[4];
#pragma unroll
                    for (int q = 0; q < 4; ++q) { const size_t j = i + q * step; const float* src = srcb + (j < NCH ? j : i) * 8; x0[q] = __builtin_nontemporal_load((const f32x4*)src); x1[q] = __builtin_nontemporal_load((const f32x4*)(src + 4)); }
#pragma unroll
                    for (int q = 0; q < 4; ++q) { const size_t j = i + q * step; if (j < NCH) *(u32x4*)(dstb + j * 8) = (u32x4){pk2(x0[q][0], x0[q][1]), pk2(x0[q][2], x0[q][3]), pk2(x1[q][0], x1[q][1]), pk2(x1[q][2], x1[q][3])}; }
                }
            }
        }
    }
    GRID_SYNC();
    {
        pg8::Gemm g{OB, Wgo, MP, 1024, 1024}; pg8::StaticOrder S; S.init(MP, 1024, G, bx);
        EpiRes E{IN(I_XP), IN(I_XS), out + O_Y, XM, ssq1, mod0 + 2048, mod0 + 4096, IN(I_NFFN), 0};
        for (int it = bx; it < 256; it += G) thin_res_item(OB, Wgo, 1024, it, E);
        pg8::gemm_phase<EpiRes, pg8::StaticOrder, true, true, false>(lds, g, S, E, lds + XL_OFF);
    }
    GRID_SYNC();
    {
        const float* modl = 0 == 0 ? mod0 : mod1;
        const float* cw = IN(I_FCW) + (size_t)0 * 3 * FF2; const float* cb = IN(I_FCB) + (size_t)0 * FF2;
    for (int rep_ = 0; rep_ < REP_U; ++rep_)
        {
            pg8::Gemm g{XM, WU(0), MTOT, FF2, 1024}; pg8::StaticOrder S; S.init(MTOT, FF2, G, bx);
            EpiUp E{ACT, Hf, Hl, 0 == 0 ? ssq1 : ssq3, shW + (0 == 0 ? SHW_UP0 : SHW_UP1), cw, cb, IN(I_SCONV) + (size_t)0 * 16 * 2 * FF2,
                    out + O_CP + (size_t)0 * 32 * 2 * FF2, out + O_CS + (size_t)0 * 16 * 2 * FF2};
            pg8::gemm_phase<EpiUp, pg8::StaticOrder, true, true, true>(lds, g, S, E, lds + XL_OFF);
        }
        GRID_SYNC();
        {
            pg8::Gemm g{ACT, WD(0), MP, 1024, FF}; pg8::StaticOrder S; S.init(MP, 1024, G, bx);
            ffn_fixup(S, ACT, Hf, Hl, cw, cb);
            EpiRes E{out + O_Y, out + O_Y + (size_t)MP * DM, out + O_Y, XM, ssq2, modl + 5120, mod1 + 1024, IN(I_NMIX) + 1024, 0};
            for (int it = bx; it < 256; it += G) thin_res_item(ACT, WD(0), FF, it, E);
            pg8::gemm_phase<EpiRes, pg8::StaticOrder, true, true, false>(lds, g, S, E, lds + XL_OFF);
        }
        GRID_SYNC();
    for (int rep_ = 0; rep_ < REP_G; ++rep_)
        {
            pg8::Gemm g{XM, Wdi, MTOT, DIN, 1024}; pg8::StaticOrder S; S.init(MTOT, DIN, G, bx);
            EpiDiffIn E{QKVR, QKVR + (size_t)MTOT * DM, QKVR + (size_t)2 * MTOT * DM, out + O_KP, out + O_KS, out + O_VP, out + O_VS, ssq2, shW + SHW_DIF, IN(I_DQN), IN(I_DKN)};
            pg8::gemm_phase<EpiDiffIn, pg8::StaticOrder, true, true, false>(lds, g, S, E, lds + XL_OFF);
        }
        GRID_SYNC();
    for (int rep_ = 0; rep_ < REP_A; ++rep_)
        {
            const float* dl = IN(I_DLAM);
            const float s1 = wave_sum(dl[lane] * dl[64 + lane]), s2 = wave_sum(dl[128 + lane] * dl[192 + lane]);
            const float lam = __expf(s1) - __expf(s2) + LAM_INIT1;
            AttnSrc A{QKVR, QKVR + (size_t)MTOT * DM, QKVR + (size_t)2 * MTOT * DM, KC, VC, OB, IN(I_DNORM)};
            const int vcu = (G % 8 == 0) ? (bx & 7) * (G >> 3) + (bx >> 3) : bx;
            for (int pi = vcu; pi < 2048; pi += G) {
                const int bh = pi >> 3, s = pi & 7;
                attn_unit(A, 0, bh >> 3, bh & 7, s, lam, lds);
                attn_unit(A, 0, bh >> 3, bh & 7, 15 - s, lam, lds);
            }
            for (int su = bx; su < 128; su += G) attn_unit(A, 1, su >> 3, su & 7, 0, lam, lds);
        }
        GRID_SYNC();
        {
            pg8::Gemm g{OB, Wdo, MP, 1024, 1024}; pg8::StaticOrder S; S.init(MP, 1024, G, bx);
            EpiRes E{out + O_Y, out + O_Y + (size_t)MP * DM, out + O_Y, XM, ssq3, mod1 + 2048, mod1 + 4096, IN(I_NFFN) + 1024, 0};
            for (int it = bx; it < 256; it += G) thin_res_item(OB, Wdo, 1024, it, E);
            pg8::gemm_phase<EpiRes, pg8::StaticOrder, true, true, false>(lds, g, S, E, lds + XL_OFF);
        }
        GRID_SYNC();
    }
    {
        const float* modl = 1 == 0 ? mod0 : mod1;
        const float* cw = IN(I_FCW) + (size_t)1 * 3 * FF2; const float* cb = IN(I_FCB) + (size_t)1 * FF2;
    for (int rep_ = 0; rep_ < 1; ++rep_)
        {
            pg8::Gemm g{XM, WU(1), MTOT, FF2, 1024}; pg8::StaticOrder S; S.init(MTOT, FF2, G, bx);
            EpiUp E{ACT, Hf, Hl, 1 == 0 ? ssq1 : ssq3, shW + (1 == 0 ? SHW_UP0 : SHW_UP1), cw, cb, IN(I_SCONV) + (size_t)1 * 16 * 2 * FF2,
                    out + O_CP + (size_t)1 * 32 * 2 * FF2, out + O_CS + (size_t)1 * 16 * 2 * FF2};
            pg8::gemm_phase<EpiUp, pg8::StaticOrder, true, true, true>(lds, g, S, E, lds + XL_OFF);
        }
        GRID_SYNC();
        {
            pg8::Gemm g{ACT, WD(1), MP, 1024, FF}; pg8::StaticOrder S; S.init(MP, 1024, G, bx);
            ffn_fixup(S, ACT, Hf, Hl, cw, cb);
            EpiRes E{out + O_Y, out + O_Y + (size_t)MP * DM, out + O_Y, XM, ssq2, modl + 5120, mod1 + 1024, IN(I_NMIX) + 1024, 1};
            for (int it = bx; it < 256; it += G) thin_res_item(ACT, WD(1), FF, it, E);
            pg8::gemm_phase<EpiRes, pg8::StaticOrder, true, true, false>(lds, g, S, E, lds + XL_OFF);
        }
    }
}

#undef out
#undef mod
extern "C" void kernel_launch(void* const* d_in, const int* in_sizes, int n_in, void* d_out, int out_size, void* d_ws, size_t ws_size, hipStream_t stream) {
    static int inited = 0;
    if (!inited) {
        (void)hipFuncSetAttribute((const void*)fwd, hipFuncAttributeMaxDynamicSharedMemorySize, LDS_BYTES);
        int per_cu = 0; (void)hipOccupancyMaxActiveBlocksPerMultiprocessor(&per_cu, (const void*)fwd, 512, LDS_BYTES);
        if (n_in != 27 || ws_size < WS_END || per_cu < 1) fprintf(stderr, "kernel_launch: n_in %d ws %zu per_cu %d out %d\n", n_in, ws_size, per_cu, out_size);
        inited = 1;
    }
    Args a{};
    for (int i = 0; i < 27; ++i) a.in[i] = (const float*)d_in[i];
    a.out = (float*)d_out; a.ws = (unsigned char*)d_ws;
    (void)hipMemsetAsync((unsigned char*)d_ws + WS_BAR, 0, 16384, stream);
    void* args[] = {&a};
    hipError_t e = hipLaunchCooperativeKernel((const void*)fwd, dim3(256), dim3(512), args, LDS_BYTES, stream);
    if (e != hipSuccess) fprintf(stderr, "cooperative launch failed: %s\n", hipGetErrorString(e));
}
```
